# Optimizing an MI355X kernel written in HIP

```python
import jax
import jax.numpy as jnp
from jax import lax
import numpy as np

D_MODEL = 1024
BATCH = 32
SEQ = 2048
DEPTH = 2

GRID_W = 64
CTX_LEN = 256
CHUNK = 128
EPS = 1e-6
N_MOD = 6

A_GROUPS = 4
A_DIM = 512
A_GDIM = A_DIM // A_GROUPS
B_HEADS = 4
B_HEAD_DIM = 128
B_DIM = B_HEADS * B_HEAD_DIM
N_GATES = 4
MIX_DIM = A_DIM + B_DIM
K_OFF = 0
V_OFF = K_OFF + B_DIM
G_OFF = V_OFF + B_DIM
Q_OFF = G_OFF + N_GATES * B_HEADS
O_OFF = Q_OFF + B_DIM
U_OFF = O_OFF + B_DIM
VA_OFF = U_OFF + A_DIM
AB_PROJ = VA_OFF + A_DIM
C_HEADS = 4
C_QK_DIM = 256
C_V_DIM = 512
RK_OFF = 0
RV_OFF = RK_OFF + C_HEADS * C_QK_DIM
RQ_OFF = RV_OFF + C_HEADS * C_V_DIM
RG_OFF = RQ_OFF + C_HEADS * C_QK_DIM
C_PROJ = RG_OFF + C_HEADS * C_V_DIM
D_FF = 2816
N_EVEN = (DEPTH + 1) // 2
N_ODD = DEPTH // 2

kernel_name = "hybrid_sgu_mlstm_retention_dit"


def _rms(x, g):
    xf = x.astype(jnp.float32)
    y = xf * lax.rsqrt(jnp.mean(xf * xf, axis=-1, keepdims=True) + EPS)
    return (y * g).astype(x.dtype)


def _ln(x):
    xf = x.astype(jnp.float32)
    xc = xf - jnp.mean(xf, axis=-1, keepdims=True)
    return (xc * lax.rsqrt(jnp.mean(xc * xc, axis=-1, keepdims=True) + EPS)).astype(x.dtype)


def _heads(t, nh):
    b, l, w = t.shape
    return t.reshape(b, l, nh, w // nh).transpose(0, 2, 1, 3)


def _head_norm(y, g):
    b, nh, l, d = y.shape
    yn = _ln(y.astype(jnp.float32))
    return yn.transpose(0, 2, 1, 3).reshape(b, l, nh * d) * g


def _to_chunks(t):
    b, h, l = t.shape[:3]
    return jnp.moveaxis(t.reshape(b, h, l // CHUNK, CHUNK, *t.shape[3:]), 2, 0)


def _from_chunks(t):
    t = jnp.moveaxis(t, 0, 2)
    return t.reshape(t.shape[0], t.shape[1], -1, *t.shape[4:])


def _dwconv1d(x, w):
    xp = jnp.pad(x, ((0, 0), (1, 1), (0, 0)))
    return xp[:, :-2] * w[0] + xp[:, 1:-1] * w[1] + xp[:, 2:] * w[2]


def _dwconv_grid(x, w):
    b, s, ch = x.shape
    rows = s // GRID_W
    img = x.reshape(b, rows, GRID_W, ch)
    y = lax.conv_general_dilated(img, w[:, :, None, :], window_strides=(1, 1), padding="SAME",
                                 dimension_numbers=("NHWC", "HWIO", "NHWC"), feature_group_count=ch)
    return y.reshape(b, s, ch)


def _conv_glu(h, w_up, w_conv, w_down, grid):
    a, g = jnp.split(h @ w_up, 2, axis=-1)
    g = _dwconv_grid(g, w_conv) if grid else _dwconv1d(g, w_conv[1])
    return (jax.nn.gelu(g) * a) @ w_down


def _bidir_scan(scan_fn, init, q_l, in_l, q_c, in_c):
    outs_l, outs_c = [], []
    for d in range(2):
        rev = (lambda t: t) if d == 0 else (lambda t: None if t is None else jnp.flip(t, 2))
        state, o_c = scan_fn(d, [rev(t) for t in in_c], init, rev(q_c))
        _, o_l = scan_fn(d, [rev(t) for t in in_l], state, rev(q_l))
        outs_l.append(rev(o_l))
        outs_c.append(rev(o_c))
    y_c = None if q_c is None else outs_c[0] + outs_c[1]
    return outs_l[0] + outs_l[1], y_c


def _mlstm_scan(direction, inputs, state, q):
    k, v, gates = inputs
    with_q = q is not None
    ig = gates[..., 2 * direction]
    lf = jax.nn.log_sigmoid(gates[..., 2 * direction + 1])
    lower = jnp.tril(jnp.ones((CHUNK, CHUNK), dtype=bool))
    xs = (_to_chunks(k), _to_chunks(v), _to_chunks(ig), _to_chunks(lf))
    if with_q:
        xs = xs + (_to_chunks(q),)

    def step(carry, inp):
        c_mem, n_mem, m = carry
        kc, vc, ic, fc = inp[0], inp[1], inp[2], inp[3]
        bcum = jnp.cumsum(fc, axis=-1)
        btot = bcum[..., -1]
        src = btot[..., None] - bcum + ic
        m_new = jnp.maximum(btot + m, jnp.max(src, axis=-1))
        kw = kc * jnp.exp(src - m_new[..., None])[..., None]
        decay_prev = jnp.exp(btot + m - m_new)
        c_new = decay_prev[..., None, None] * c_mem + jnp.einsum("bhsk,bhsv->bhkv", kw, vc)
        n_new = decay_prev[..., None] * n_mem + jnp.sum(kw, axis=2)
        if not with_q:
            return (c_new, n_new, m_new), None
        qc = inp[4]
        log_d = jnp.where(lower, bcum[..., :, None] - bcum[..., None, :] + ic[..., None, :], -jnp.inf)
        log_prev = bcum + m[..., None]
        m_t = jnp.maximum(log_prev, jnp.max(log_d, axis=-1))
        scores = jnp.einsum("bhtk,bhsk->bhts", qc, kc) * jnp.exp(log_d - m_t[..., None])
        w_prev = jnp.exp(log_prev - m_t)
        num = jnp.einsum("bhts,bhsv->bhtv", scores, vc) + w_prev[..., None] * jnp.einsum("bhtk,bhkv->bhtv", qc, c_mem)
        den = jnp.sum(scores, axis=-1) + w_prev * jnp.einsum("bhtk,bhk->bht", qc, n_mem)
        out = num / jnp.maximum(jnp.abs(den), jnp.exp(-m_t))[..., None]
        return (c_new, n_new, m_new), out

    state, ys = lax.scan(step, state, xs)
    return state, (_from_chunks(ys) if with_q else None)


def _ret_scan(log_g, inputs, state, q):
    k, v = inputs
    with_q = q is not None
    lg = log_g[:, None]
    pos = jnp.arange(CHUNK, dtype=jnp.float32)
    rel = pos[:, None] - pos[None, :]
    d_intra = jnp.exp(jnp.where(rel >= 0, lg[..., None] * rel, -jnp.inf))
    zeta = jnp.exp(lg * (CHUNK - 1 - pos))
    xi = jnp.exp(lg * (pos + 1))
    g_chunk = jnp.exp(log_g * CHUNK)
    xs = (_to_chunks(k), _to_chunks(v))
    if with_q:
        xs = xs + (_to_chunks(q),)

    def step(r_mem, inp):
        kc, vc = inp[0], inp[1]
        r_new = g_chunk[:, None, None] * r_mem + jnp.einsum("bhsk,bhsv->bhkv", kc * zeta[:, :, None], vc)
        if not with_q:
            return r_new, None
        qc = inp[2]
        scores = jnp.einsum("bhtk,bhsk->bhts", qc, kc) * d_intra
        out = jnp.einsum("bhts,bhsv->bhtv", scores, vc) + xi[:, :, None] * jnp.einsum("bhtk,bhkv->bhtv", qc, r_mem)
        return r_new, out

    state, ys = lax.scan(step, state, xs)
    return state, (_from_chunks(ys) if with_q else None)


def _chunk_sgu(u, v, w_s, b_s):
    b, l, _ = v.shape
    vc = _ln(v).reshape(b, l // CHUNK, CHUNK, A_GROUPS, A_GDIM)
    mixed = jnp.einsum("gpq,bnqgd->bnpgd", w_s, vc) + b_s.T[:, :, None]
    return u * mixed.reshape(b, l, A_DIM)


def _mlstm_in(p, qk_conv, gate_b, with_q):
    b, l, _ = p.shape
    k = _heads(jax.nn.silu(_dwconv1d(p[..., K_OFF:V_OFF], qk_conv[:, B_DIM:])), B_HEADS) * B_HEAD_DIM ** -0.5
    v = _heads(p[..., V_OFF:G_OFF], B_HEADS)
    gates = (p[..., G_OFF:Q_OFF].reshape(b, l, N_GATES, B_HEADS).astype(jnp.float32) + gate_b).transpose(0, 3, 1, 2)
    q = _heads(jax.nn.silu(_dwconv1d(p[..., Q_OFF:O_OFF], qk_conv[:, :B_DIM])), B_HEADS) if with_q else None
    return q, [k, v, gates]


def _ab_mixer(h_l, h_c, w_in, qk_conv, gate_b, sgu_w, sgu_b, head_g, w_out, ctx_out):
    p_l = h_l @ w_in
    p_c = h_c @ (w_in if ctx_out else w_in[:, :Q_OFF])
    q_l, in_l = _mlstm_in(p_l, qk_conv, gate_b, True)
    q_c, in_c = _mlstm_in(p_c, qk_conv, gate_b, ctx_out)
    b = h_l.shape[0]
    init = (jnp.zeros((b, B_HEADS, B_HEAD_DIM, B_HEAD_DIM), jnp.float32),
            jnp.zeros((b, B_HEADS, B_HEAD_DIM), jnp.float32),
            jnp.zeros((b, B_HEADS), jnp.float32))
    r_l, r_c = _bidir_scan(_mlstm_scan, init, q_l, in_l, q_c, in_c)

    def merge(p, r):
        u = jax.nn.gelu(p[..., U_OFF:VA_OFF])
        va = jax.nn.gelu(p[..., VA_OFF:])
        o = _heads(jax.nn.sigmoid(p[..., O_OFF:U_OFF]), B_HEADS)
        mem = _head_norm(o * r, head_g).astype(u.dtype)
        return jnp.concatenate([_chunk_sgu(u, va, sgu_w, sgu_b), mem], axis=-1) @ w_out

    return merge(p_l, r_l), (merge(p_c, r_c) if ctx_out else None)


def _ret_in(p, with_q):
    k = _heads(p[..., RK_OFF:RV_OFF], C_HEADS) * C_QK_DIM ** -0.5
    v = _heads(p[..., RV_OFF:RQ_OFF], C_HEADS)
    q = _heads(p[..., RQ_OFF:RG_OFF], C_HEADS) if with_q else None
    return q, [k, v]


def _ret_mixer(h_l, h_c, w_in, decay_logit, head_g, w_out, ctx_out):
    p_l = h_l @ w_in
    p_c = h_c @ (w_in if ctx_out else w_in[:, :RQ_OFF])
    q_l, in_l = _ret_in(p_l, True)
    q_c, in_c = _ret_in(p_c, ctx_out)
    log_g = jax.nn.log_sigmoid(decay_logit.astype(jnp.float32))
    init = jnp.zeros((h_l.shape[0], C_HEADS, C_QK_DIM, C_V_DIM), jnp.float32)
    r_l, r_c = _bidir_scan(lambda d, inp, st, q: _ret_scan(log_g[d], inp, st, q), init, q_l, in_l, q_c, in_c)

    def merge(p, r):
        return (jax.nn.silu(p[..., RG_OFF:]) * _head_norm(r, head_g)) @ w_out

    return merge(p_l, r_l), (merge(p_c, r_c) if ctx_out else None)


def setup_inputs(seed: int = 0) -> dict:
    key = jax.random.key(seed)
    ks = iter(jax.random.split(key, 32))

    def nrm(shape, scale):
        return jax.random.normal(next(ks), shape, jnp.float32) * scale

    gamma0 = 1.0 - 2.0 ** (-5.0 - jnp.arange(C_HEADS, dtype=jnp.float32))
    decay_logit0 = jnp.log(gamma0) - jnp.log1p(-gamma0)
    gate_base = jnp.array([0.0, 4.0, 0.0, 4.0], jnp.float32)[:, None]
    return {
        "x": nrm((BATCH, SEQ, D_MODEL), 1.0),
        "c": nrm((BATCH, D_MODEL), 1.0),
        "ctx": nrm((BATCH, CTX_LEN, D_MODEL), 1.0),
        "c_ctx": nrm((D_MODEL,), 1.0),
        "ada_w": nrm((DEPTH, D_MODEL, N_MOD * D_MODEL), 0.5 * D_MODEL ** -0.5),
        "ada_b": nrm((DEPTH, N_MOD * D_MODEL), 0.02),
        "pre_g": 1.0 + nrm((DEPTH, 2, D_MODEL), 0.05),
        "post_g": 1.0 + nrm((DEPTH, 2, D_MODEL), 0.05),
        "ffn_up": nrm((DEPTH, D_MODEL, 2 * D_FF), D_MODEL ** -0.5),
        "ffn_conv": nrm((DEPTH, 3, 3, D_FF), 1.0 / 3.0),
        "ffn_down": nrm((DEPTH, D_FF, D_MODEL), D_FF ** -0.5),
        "ab_w_in": nrm((N_EVEN, D_MODEL, AB_PROJ), D_MODEL ** -0.5),
        "ab_qk_conv": nrm((N_EVEN, 3, 2 * B_DIM), 3.0 ** -0.5),
        "ab_gate_b": gate_base + nrm((N_EVEN, N_GATES, B_HEADS), 0.1),
        "ab_sgu_w": nrm((N_EVEN, A_GROUPS, CHUNK, CHUNK), CHUNK ** -0.5),
        "ab_sgu_b": nrm((N_EVEN, A_GROUPS, CHUNK), 0.02),
        "ab_head_g": 1.0 + nrm((N_EVEN, B_DIM), 0.05),
        "ab_w_out": nrm((N_EVEN, MIX_DIM, D_MODEL), MIX_DIM ** -0.5),
        "ret_w_in": nrm((N_ODD, D_MODEL, C_PROJ), D_MODEL ** -0.5),
        "ret_decay": decay_logit0 + nrm((N_ODD, 2, C_HEADS), 0.1),
        "ret_head_g": 1.0 + nrm((N_ODD, C_HEADS * C_V_DIM), 0.05),
        "ret_w_out": nrm((N_ODD, C_HEADS * C_V_DIM, D_MODEL), (C_HEADS * C_V_DIM) ** -0.5),
    }


def reference(x, c, ctx, c_ctx, ada_w, ada_b, pre_g, post_g, ffn_up, ffn_conv, ffn_down,
              ab_w_in, ab_qk_conv, ab_gate_b, ab_sgu_w, ab_sgu_b, ab_head_g, ab_w_out,
              ret_w_in, ret_decay, ret_head_g, ret_w_out):
    s_lat = jax.nn.silu(c)
    s_ctx = jax.nn.silu(c_ctx)
    for layer in range(DEPTH):
        last = layer == DEPTH - 1
        j = layer // 2
        m_l = [t[:, None, :] for t in jnp.split(s_lat @ ada_w[layer] + ada_b[layer], N_MOD, axis=-1)]
        m_c = jnp.split(s_ctx @ ada_w[layer] + ada_b[layer], N_MOD, axis=-1)
        h_l = _rms(x, pre_g[layer, 0]) * (1.0 + m_l[1]) + m_l[0]
        h_c = _rms(ctx, pre_g[layer, 0]) * (1.0 + m_c[1]) + m_c[0]
        if layer % 2 == 0:
            y_l, y_c = _ab_mixer(h_l, h_c, ab_w_in[j], ab_qk_conv[j], ab_gate_b[j], ab_sgu_w[j], ab_sgu_b[j],
                                 ab_head_g[j], ab_w_out[j], not last)
        else:
            y_l, y_c = _ret_mixer(h_l, h_c, ret_w_in[j], ret_decay[j], ret_head_g[j], ret_w_out[j], not last)
        x = x + (m_l[2] * _rms(y_l, post_g[layer, 0])).astype(x.dtype)
        f_l = _conv_glu(_rms(x, pre_g[layer, 1]) * (1.0 + m_l[4]) + m_l[3],
                        ffn_up[layer], ffn_conv[layer], ffn_down[layer], True)
        x = x + (m_l[5] * _rms(f_l, post_g[layer, 1])).astype(x.dtype)
        if not last:
            ctx = ctx + (m_c[2] * _rms(y_c, post_g[layer, 0])).astype(ctx.dtype)
            f_c = _conv_glu(_rms(ctx, pre_g[layer, 1]) * (1.0 + m_c[4]) + m_c[3],
                            ffn_up[layer], ffn_conv[layer], ffn_down[layer], False)
            ctx = ctx + (m_c[5] * _rms(f_c, post_g[layer, 1])).astype(ctx.dtype)
    return x
```

```cpp
#include <hip/hip_runtime.h>
#include <hip/hip_cooperative_groups.h>
#include <cstdio>
#include <cstdint>
namespace cg = cooperative_groups;

#ifndef MK_MULTI
#define MK_MULTI 0
#endif

#define LAS __attribute__((address_space(3)))
typedef unsigned short bf16_t;
typedef short bf16x8 __attribute__((ext_vector_type(8)));
typedef float f32x4 __attribute__((ext_vector_type(4)));
typedef unsigned u32x4 __attribute__((ext_vector_type(4)));
typedef unsigned u32x2 __attribute__((ext_vector_type(2)));

constexpr int D = 1024, NBATCH = 32, SEQ = 2048, CTXL = 256, LT = 2304;
constexpr int NB = 16, NGRP = NBATCH / NB;
constexpr int TG = NB * LT;
constexpr int TL = NB * SEQ;
constexpr int DFF = 2816;
constexpr int LDS_BYTES = 147456;
constexpr int NPHASE = 1 + NGRP * 21;
constexpr float LOG2E = 1.4426950408889634f;
constexpr int XCD_BAR_WORDS_C = 3456;

constexpr size_t al256(size_t x) { return (x + 255) & ~(size_t)255; }
constexpr size_t OFF_MOD  = 0;
constexpr size_t OFF_W0N  = al256(OFF_MOD + (size_t)2 * 33 * 6144 * 4);
constexpr size_t OFF_W0T  = OFF_W0N + (size_t)2048 * 1024 * 2;
constexpr size_t OFF_WO0  = OFF_W0T + (size_t)1024 * 1024 * 2;
constexpr size_t OFF_WUP0 = OFF_WO0 + (size_t)1024 * 1024 * 2;
constexpr size_t OFF_WUP1 = OFF_WUP0 + (size_t)5632 * 1024 * 2;
constexpr size_t OFF_WDN0 = OFF_WUP1 + (size_t)5632 * 1024 * 2;
constexpr size_t OFF_WDN1 = OFF_WDN0 + (size_t)1024 * 2816 * 2;
constexpr size_t OFF_W1N  = OFF_WDN1 + (size_t)1024 * 2816 * 2;
constexpr size_t OFF_W1T  = OFF_W1N + (size_t)4096 * 1024 * 2;
constexpr size_t OFF_WO1  = OFF_W1T + (size_t)2048 * 1024 * 2;
constexpr size_t OFF_SGUW = OFF_WO1 + (size_t)1024 * 2048 * 2;
constexpr size_t OFF_ROWT = OFF_SGUW + (size_t)4 * 128 * 128 * 2;
constexpr size_t OFF_COLT = OFF_ROWT + (size_t)NB * 8 * LT * 4;
constexpr size_t OFF_ENM  = OFF_COLT + (size_t)NB * 8 * LT * 4;
constexpr size_t OFF_GATES= OFF_ENM + (size_t)NB * 8 * LT * 4;
constexpr size_t OFF_CTXR = OFF_GATES + (size_t)TG * 16 * 4;
constexpr size_t OFF_H    = OFF_CTXR + (size_t)NB * 256 * 1024 * 4;
constexpr size_t OFF_Y    = OFF_H + (size_t)TG * 1024 * 2;
constexpr size_t OFF_BIG  = OFF_Y + (size_t)TG * 1024 * 2;
constexpr size_t OFF_PN   = OFF_BIG;
constexpr size_t OFF_VT0  = OFF_PN + (size_t)TG * 2048 * 2;
constexpr size_t OFF_QC   = OFF_VT0 + (size_t)1024 * TG * 2;
constexpr size_t OFF_KC   = OFF_QC + (size_t)TG * 512 * 2;
constexpr size_t OFF_RF   = OFF_KC + (size_t)TG * 512 * 2;
constexpr size_t OFF_RB   = OFF_RF + (size_t)TG * 512 * 2;
constexpr size_t OFF_AG   = OFF_BIG;
constexpr size_t OFF_ACT  = OFF_AG + (size_t)TG * 5632 * 2;
constexpr size_t OFF_K1   = OFF_BIG;
constexpr size_t OFF_Q1   = OFF_K1 + (size_t)TG * 1024 * 2;
constexpr size_t OFF_G1   = OFF_Q1 + (size_t)TG * 1024 * 2;
constexpr size_t OFF_VT1  = OFF_G1 + (size_t)TG * 2048 * 2;
constexpr size_t OFF_K1T  = OFF_VT1 + (size_t)2048 * TG * 2;
constexpr size_t OFF_MRG  = OFF_K1T + (size_t)1024 * TG * 2;
constexpr size_t END_FFN  = OFF_ACT + (size_t)TG * 2816 * 2;
constexpr size_t OFF_MRG2 = OFF_MRG + (size_t)TL * 2048 * 2;
constexpr size_t END_MIX1 = OFF_MRG2 + (size_t)TL * 2048 * 2;
constexpr size_t OFF_BAR  = al256(END_FFN > END_MIX1 ? END_FFN : END_MIX1);
constexpr size_t WS_END   = OFF_BAR + (size_t)XCD_BAR_WORDS_C * 4;
static_assert(WS_END <= (size_t)1020 * 1024 * 1024, "workspace budget");
static_assert(OFF_RB + (size_t)TG * 512 * 2 <= END_FFN, "mixer0 region");

__device__ __forceinline__ unsigned f2bf(float f) { unsigned u = __float_as_uint(f); return (u + 0x7fffu + ((u >> 16) & 1u)) >> 16; }
__device__ __forceinline__ unsigned pk2(float lo, float hi) { return f2bf(lo) | (f2bf(hi) << 16); }
__device__ __forceinline__ float bf2f(bf16_t b) { return __uint_as_float(((unsigned)b) << 16); }
__device__ __forceinline__ float bflo(unsigned w) { return __uint_as_float(w << 16); }
__device__ __forceinline__ float bfhi(unsigned w) { return __uint_as_float(w & 0xffff0000u); }
__device__ __forceinline__ unsigned cvt_pk_bf16(float lo, float hi) { unsigned r; asm volatile("v_cvt_pk_bf16_f32 %0, %1, %2" : "=v"(r) : "v"(lo), "v"(hi)); return r; }
__device__ __forceinline__ float fast_exp2(float x) { return __builtin_amdgcn_exp2f(x); }
__device__ __forceinline__ float fast_rcp(float x) { return __builtin_amdgcn_rcpf(x); }
__device__ __forceinline__ float logsig(float x) { return fminf(x, 0.f) - 0.6931471805599453f * __builtin_amdgcn_logf(1.0f + fast_exp2(-fabsf(x) * LOG2E)); }
__device__ __forceinline__ float sigmoid_f(float x) { return fast_rcp(1.0f + fast_exp2(-x * LOG2E)); }
__device__ __forceinline__ float silu_f(float x) { return x * sigmoid_f(x); }
__device__ __forceinline__ float gelu_f(float x) {
    const float u = 0.7978845608028654f * (x + 0.044715f * x * x * x);
    return x * fast_rcp(1.0f + fast_exp2(-2.0f * LOG2E * u));
}
__device__ __forceinline__ float shfl_idx(float v, int src) { return __int_as_float(__builtin_amdgcn_ds_bpermute(src << 2, __float_as_int(v))); }
__device__ __forceinline__ float shfl_xor_l(float v, int m, int lane) { return shfl_idx(v, lane ^ m); }
__device__ __forceinline__ float shfl_up_l(float v, int o, int lane) { return shfl_idx(v, (lane - o) & 63); }
__device__ __forceinline__ float wave_sum(float v, int lane) {
#pragma unroll
    for (int o = 1; o < 64; o <<= 1) v += shfl_xor_l(v, o, lane);
    return v;
}
__device__ __forceinline__ void unpack8(const u32x4 w, float (&f)[8]) {
    f[0] = bflo(w.x); f[1] = bfhi(w.x); f[2] = bflo(w.y); f[3] = bfhi(w.y); f[4] = bflo(w.z); f[5] = bfhi(w.z); f[6] = bflo(w.w); f[7] = bfhi(w.w);
}
#define LDS_WAIT() asm volatile("s_waitcnt lgkmcnt(0)" ::: "memory")

namespace pg8 {
constexpr int BM = 256, BK = 64, HALF = 128, HTB = HALF * BK * 2, STAGE_BYTES = 8 * HTB, NXCD = 8, WGM = 8;
__host__ __device__ __forceinline__ int lds_byte(int r, int c) { const int st = (r >> 4) * 2 + (c >> 5), rr = r & 15, cc = c & 31, ob = rr * 64 + cc * 2; return st * 1024 + (ob ^ (((ob >> 9) & 1) << 5)); }
__host__ __device__ __forceinline__ void stage_rc(int b, int& R, int& C) { const int st = b / 1024, sb = b % 1024, swz = sb ^ (((sb >> 9) & 1) << 5); R = (st >> 1) * 16 + swz / 64; C = (st & 1) * 32 + (swz % 64) / 2; }
__host__ __device__ __forceinline__ int perm32(int rho) { const int n = rho >> 4, i = rho & 15; return 8 * (i >> 2) + 4 * n + (i & 3); }

enum { ACT_NONE = 0, ACT_GELU = 1, ACT_SIGMOID = 2, ACT_SILU = 3, ACT_GATES = 9 };
struct Unit { const char* a; const char* b; bf16_t* o; int ldc; int act; float scale; };

enum { G_L0IN = 0, G_OUT0, G_UP0, G_DN0, G_L1IN, G_OUT1, G_UP1, G_DN1, G_L1B, G_DN0C };
template <int PH> struct Sched {
    unsigned char* ws; int G, c;
    static constexpr int KDIM = (PH == G_DN0 || PH == G_DN1 || PH == G_DN0C) ? DFF : (PH == G_OUT1 ? 2048 : 1024);
    static constexpr size_t tstep = (size_t)256 * KDIM * 2;
    static constexpr int MT = TG / 256, ML = TL / 256;
    static constexpr int N0 = PH == G_L0IN ? MT * 8 : PH == G_OUT0 ? MT * 4 : PH == G_UP0 ? MT * 22 : PH == G_DN0 ? ML * 4 : PH == G_DN0C ? (MT - ML) * 4 : PH == G_L1IN ? MT * 4 : PH == G_OUT1 ? ML * 4 : PH == G_UP1 ? ML * 22 : PH == G_L1B ? ML * 12 : ML * 4;
    static constexpr int N1 = PH == G_L0IN ? 4 * MT : PH == G_L1IN ? 8 * MT : 0;
    static constexpr int N2 = 0;
    static constexpr int N3 = 0;
    static __device__ __forceinline__ void tile(int wgid, int nM, int nN, int& pm, int& pn) {
        const int nwg = nM * nN;
        { const int q = nwg / NXCD, r = nwg % NXCD, xcd = wgid % NXCD, off = wgid / NXCD; wgid = (xcd < r ? xcd * (q + 1) : r * (q + 1) + (xcd - r) * q) + off; }
        const int nig = WGM * nN, gid = wgid / nig, fm = gid * WGM, gsz = (nM - fm) < WGM ? (nM - fm) : WGM;
        pm = fm + ((wgid % nig) % gsz); pn = (wgid % nig) / gsz;
    }
    __device__ __forceinline__ void plain(int L, size_t offA, size_t offB, size_t offO, int nM, int nN, Unit& u) const {
        int pm, pn; tile(L, nM, nN, pm, pn);
        u.a = (const char*)ws + offA + (size_t)pm * tstep; u.b = (const char*)ws + offB + (size_t)pn * tstep;
        u.ldc = nN * 256; u.o = (bf16_t*)(ws + offO) + (size_t)pm * 256 * (nN * 256) + pn * 256;
    }
    __device__ __forceinline__ bool next(int i, Unit& u) const {
        const long LL = (long)i * G + c;
        if (LL >= (long)N0 + N1 + N2 + N3) return false;
        const int L = (int)LL;
        u.scale = 1.0f; u.act = ACT_NONE;
        if constexpr (PH == G_L0IN) {
            if (L < N0) { int pm, pn; tile(L, MT, 8, pm, pn);
                u.a = (const char*)ws + OFF_H + (size_t)pm * tstep; u.b = (const char*)ws + OFF_W0N + (size_t)pn * tstep;
                u.o = (bf16_t*)(ws + OFF_PN) + (size_t)pm * 256 * 2048 + pn * 256; u.ldc = 2048; u.act = pn < 4 ? ACT_NONE : (pn < 6 ? ACT_SIGMOID : ACT_GELU);
            } else { int pm, pn; tile(L - N0, 4, MT, pm, pn);
                u.a = (const char*)ws + OFF_W0T + (size_t)pm * tstep; u.b = (const char*)ws + OFF_H + (size_t)pn * tstep;
                u.o = (bf16_t*)(ws + OFF_VT0) + (size_t)pm * 256 * TG + pn * 256; u.ldc = TG; u.act = pm >= 2 ? ACT_GELU : ACT_NONE; }
        } else if constexpr (PH == G_L1IN) {
            if (L < N0) { int pm, pn; tile(L, MT, 4, pm, pn);
                u.a = (const char*)ws + OFF_H + (size_t)pm * tstep; u.b = (const char*)ws + OFF_W1N + (size_t)pn * tstep;
                u.ldc = 1024; u.o = (bf16_t*)(ws + OFF_K1) + (size_t)pm * 256 * 1024 + pn * 256; u.scale = 0.0625f;
            } else if (L < N0 + N1) { int pm, pn; tile(L - N0, 8, MT, pm, pn);
                u.a = (const char*)ws + OFF_W1T + (size_t)pm * tstep; u.b = (const char*)ws + OFF_H + (size_t)pn * tstep;
                u.o = (bf16_t*)(ws + OFF_VT1) + (size_t)pm * 256 * TG + pn * 256; u.ldc = TG;
            } else { int pm, pn; tile(L - N0 - N1, 4, MT, pm, pn);
                u.a = (const char*)ws + OFF_W1N + (size_t)pm * tstep; u.b = (const char*)ws + OFF_H + (size_t)pn * tstep;
                u.o = (bf16_t*)(ws + OFF_K1T) + (size_t)pm * 256 * TG + pn * 256; u.ldc = TG; u.scale = 0.0625f; }
        } else if constexpr (PH == G_L1B) {
            int pm, pn; tile(L, ML, 12, pm, pn);
            const int cm = (pm >> 3) * 9 + 1 + (pm & 7);
            u.a = (const char*)ws + OFF_H + (size_t)cm * tstep; u.b = (const char*)ws + OFF_W1N + (size_t)(4 + pn) * tstep;
            if (pn < 4) { u.ldc = 1024; u.o = (bf16_t*)(ws + OFF_Q1) + (size_t)cm * 256 * 1024 + pn * 256; }
            else { u.ldc = 2048; u.o = (bf16_t*)(ws + OFF_G1) + (size_t)cm * 256 * 2048 + (pn - 4) * 256; u.act = ACT_SILU; }
        }
        else if constexpr (PH == G_OUT0) plain(L, OFF_H, OFF_WO0, OFF_Y, MT, 4, u);
        else if constexpr (PH == G_UP0) plain(L, OFF_H, OFF_WUP0, OFF_AG, MT, 22, u);
        else if constexpr (PH == G_DN0) {
            int pm, pn; tile(L, ML, 4, pm, pn); const int cm = (pm >> 3) * 9 + 1 + (pm & 7);
            u.a = (const char*)ws + OFF_ACT + (size_t)cm * tstep; u.b = (const char*)ws + OFF_WDN0 + (size_t)pn * tstep;
            u.ldc = 1024; u.o = (bf16_t*)(ws + OFF_Y) + (size_t)cm * 256 * 1024 + pn * 256;
        } else if constexpr (PH == G_DN0C) {
            int pm, pn; tile(L, MT - ML, 4, pm, pn); const int cm = pm * 9;
            u.a = (const char*)ws + OFF_ACT + (size_t)cm * tstep; u.b = (const char*)ws + OFF_WDN0 + (size_t)pn * tstep;
            u.ldc = 1024; u.o = (bf16_t*)(ws + OFF_Y) + (size_t)cm * 256 * 1024 + pn * 256;
        }
        else if constexpr (PH == G_OUT1) plain(L, OFF_MRG, OFF_WO1, OFF_Y, ML, 4, u);
        else if constexpr (PH == G_UP1) plain(L, OFF_H, OFF_WUP1, OFF_AG, ML, 22, u);
        else plain(L, OFF_ACT, OFF_WDN1, OFF_Y, ML, 4, u);
        return true;
    }
};

__device__ __forceinline__ f32x4 act4(f32x4 v, int act, float scale) {
    if (act == ACT_GELU) { v[0] = gelu_f(v[0]); v[1] = gelu_f(v[1]); v[2] = gelu_f(v[2]); v[3] = gelu_f(v[3]); }
    else if (act == ACT_SIGMOID) { v[0] = sigmoid_f(v[0]); v[1] = sigmoid_f(v[1]); v[2] = sigmoid_f(v[2]); v[3] = sigmoid_f(v[3]); }
    else if (act == ACT_SILU) { v[0] = silu_f(v[0]); v[1] = silu_f(v[1]); v[2] = silu_f(v[2]); v[3] = silu_f(v[3]); }
    else v = v * scale;
    return v;
}
__device__ __forceinline__ void epi_store(const f32x4 (&acc)[2][2][4][2], const Unit& u, int wr, int wc, int fr, int fq) {
    const int row0 = wr * 64 + fr, col0 = wc * 32 + 8 * fq;
#pragma unroll
    for (int ai = 0; ai < 2; ++ai)
#pragma unroll
        for (int m = 0; m < 4; ++m) {
            bf16_t* rowp = u.o + (size_t)(row0 + ai * HALF + m * 16) * u.ldc + col0;
#pragma unroll
            for (int bj = 0; bj < 2; ++bj) {
                const f32x4 v0 = act4(acc[ai][bj][m][0], u.act, u.scale), v1 = act4(acc[ai][bj][m][1], u.act, u.scale);
                u32x4 w; w.x = cvt_pk_bf16(v0[0], v0[1]); w.y = cvt_pk_bf16(v0[2], v0[3]); w.z = cvt_pk_bf16(v1[0], v1[1]); w.w = cvt_pk_bf16(v1[2], v1[3]);
                *(u32x4*)(rowp + bj * HALF) = w;
            }
        }
}

template <int PH>
__device__ __forceinline__ void gemm_phase(LAS unsigned char* lds, const Sched<PH>& S, const int tid) {
    int K = Sched<PH>::KDIM; asm volatile("" : "+s"(K));
    const int wid = __builtin_amdgcn_readfirstlane(tid >> 6), lane = tid & 63, wr = wid >> 2, wc = wid & 3, fr = lane & 15, fq = lane >> 4;
    const int nt = K / BK;
    unsigned voffA[2], voffB[2];
#pragma unroll
    for (int i = 0; i < 2; ++i) { int R, C; stage_rc(tid * 16 + i * 8192, R, C); const int Rb = (R & ~31) + perm32(R & 31);
        voffA[i] = (unsigned)(R * K + C) * 2u; voffB[i] = (unsigned)(Rb * K + C) * 2u; }
    const size_t kstep = (size_t)(BK * 2);
    const size_t hstep = (size_t)HALF * K * 2;
    const unsigned ldsw = (unsigned)wid * 1024u;
    const unsigned ldsbase = (unsigned)(size_t)lds;
    const int aoff = lds_byte(wr * 64 + fr, fq * 8), boff = lds_byte(wc * 32 + fr, fq * 8);
#define PG8_SA(b, h) (((b) * 2 + (h)) * HTB)
#define PG8_SB(b, h) ((4 + (b) * 2 + (h)) * HTB)
#define PG8_STAGE(bufoff, gbase, voff) do { _Pragma("unroll") for (int _i = 0; _i < 2; ++_i) { \
        const unsigned _m0 = ldsbase + (unsigned)(bufoff) + ldsw + _i * 8192; const char* _gb = (const char*)(gbase); \
        unsigned _keep; asm volatile("s_mov_b32 %0, m0\n\ts_mov_b32 m0, %1\n\ts_nop 0\n\tglobal_load_lds_dwordx4 %2, %3\n\ts_mov_b32 m0, %0" : "=&s"(_keep) : "s"(_m0), "v"((voff)[_i]), "s"(_gb) : "memory"); } } while (0)
#define PG8_LDA(dst, b, h) do { _Pragma("unroll") for (int m = 0; m < 4; ++m) _Pragma("unroll") for (int k = 0; k < 2; ++k) dst[m][k] = *(const LAS bf16x8*)(lds + PG8_SA(b, h) + aoff + m * 2048 + k * 1024); } while (0)
#define PG8_LDB(dst, b, h) do { _Pragma("unroll") for (int n = 0; n < 2; ++n) _Pragma("unroll") for (int k = 0; k < 2; ++k) dst[n][k] = *(const LAS bf16x8*)(lds + PG8_SB(b, h) + boff + n * 2048 + k * 1024); } while (0)
#define PG8_MMA(ai, bj, At, Bt) do { __builtin_amdgcn_s_setprio(1); _Pragma("unroll") for (int m = 0; m < 4; ++m) _Pragma("unroll") for (int n = 0; n < 2; ++n) _Pragma("unroll") for (int k = 0; k < 2; ++k) \
        acc[ai][bj][m][n] = __builtin_amdgcn_mfma_f32_16x16x32_bf16(Bt[n][k], At[m][k], acc[ai][bj][m][n], 0, 0, 0); __builtin_amdgcn_s_setprio(0); } while (0)
#define PG8_WAIT_V(n) asm volatile("s_waitcnt vmcnt(" #n ")" ::: "memory")
#define PG8_WAIT_L(n) asm volatile("s_waitcnt lgkmcnt(" #n ")" ::: "memory")
#define PG8_BAR __builtin_amdgcn_s_barrier()
#define PG8_SCHED __builtin_amdgcn_sched_barrier(0)
    Unit cur, nxt; int ui = 0;
    if (!S.next(0, cur)) return;
    f32x4 acc[2][2][4][2];
#pragma unroll
    for (int a = 0; a < 2; ++a)
#pragma unroll
        for (int b = 0; b < 2; ++b)
#pragma unroll
            for (int m = 0; m < 4; ++m)
#pragma unroll
                for (int n = 0; n < 2; ++n) acc[a][b][m][n] = (f32x4){0.f, 0.f, 0.f, 0.f};
    bf16x8 At[4][2], B0[2][2], B1[2][2];
    const char* cA = cur.a; const char* cB = cur.b;
    PG8_STAGE(PG8_SB(0, 0), cB, voffB); PG8_STAGE(PG8_SB(0, 1), cB + hstep, voffB); PG8_STAGE(PG8_SA(0, 0), cA, voffA); PG8_STAGE(PG8_SA(0, 1), cA + hstep, voffA);
    if (wr == 1) PG8_BAR;
    PG8_WAIT_V(2); PG8_BAR;
    PG8_STAGE(PG8_SB(1, 0), cB + kstep, voffB); PG8_STAGE(PG8_SA(1, 0), cA + kstep, voffA); PG8_STAGE(PG8_SB(1, 1), cB + hstep + kstep, voffB);
    PG8_WAIT_V(6); PG8_BAR;
    for (;;) {
        const bool has_next = S.next(ui + 1, nxt);
        const char* nA = has_next ? nxt.a : cA; const char* nB = has_next ? nxt.b : cB;
        for (int t = 0; t < nt; t += 2) {
            const bool last = (t == nt - 2);
            const char* a1 = cA + (size_t)(t + 1) * kstep;
            const char* a2 = last ? nA : cA + (size_t)(t + 2) * kstep; const char* b2 = last ? nB : cB + (size_t)(t + 2) * kstep;
            const char* a3 = a2 + kstep; const char* b3 = b2 + kstep;
            PG8_LDB(B0, 0, 0); PG8_LDB(B1, 0, 1); PG8_SCHED; PG8_LDA(At, 0, 0); PG8_STAGE(PG8_SA(1, 1), a1 + hstep, voffA);
            PG8_WAIT_V(8); PG8_WAIT_L(0); PG8_BAR; PG8_MMA(0, 0, At, B0); PG8_MMA(0, 1, At, B1); PG8_BAR; PG8_SCHED;
            PG8_LDA(At, 0, 1); PG8_STAGE(PG8_SB(0, 0), b2, voffB); PG8_STAGE(PG8_SB(0, 1), b2 + hstep, voffB); PG8_STAGE(PG8_SA(0, 0), a2, voffA);
            PG8_WAIT_V(8); PG8_WAIT_L(0); PG8_BAR; PG8_MMA(1, 0, At, B0); PG8_MMA(1, 1, At, B1); PG8_BAR; PG8_SCHED;
            PG8_LDB(B0, 1, 0); PG8_LDB(B1, 1, 1); PG8_SCHED; PG8_LDA(At, 1, 0); PG8_STAGE(PG8_SA(0, 1), a2 + hstep, voffA);
            PG8_WAIT_V(8); PG8_WAIT_L(0); PG8_BAR; PG8_MMA(0, 0, At, B0); PG8_MMA(0, 1, At, B1); PG8_BAR; PG8_SCHED;
            PG8_LDA(At, 1, 1); PG8_STAGE(PG8_SB(1, 0), b3, voffB); PG8_STAGE(PG8_SB(1, 1), b3 + hstep, voffB); PG8_STAGE(PG8_SA(1, 0), a3, voffA);
            PG8_WAIT_V(8); PG8_WAIT_L(0); PG8_BAR; PG8_MMA(1, 0, At, B0); PG8_MMA(1, 1, At, B1); PG8_BAR; PG8_SCHED;
        }
        if (wr == 0) PG8_BAR;
        epi_store(acc, cur, wr, wc, fr, fq);
        if (!has_next) break;
#pragma unroll
        for (int a = 0; a < 2; ++a)
#pragma unroll
            for (int b = 0; b < 2; ++b)
#pragma unroll
                for (int m = 0; m < 4; ++m)
#pragma unroll
                    for (int n = 0; n < 2; ++n) acc[a][b][m][n] = (f32x4){0.f, 0.f, 0.f, 0.f};
        cur = nxt; cA = nA; cB = nB; ++ui;
        if (wr == 1) PG8_BAR;
    }
    PG8_WAIT_V(0);
    PG8_BAR;
#undef PG8_SA
#undef PG8_SB
#undef PG8_STAGE
#undef PG8_LDA
#undef PG8_LDB
#undef PG8_MMA
#undef PG8_WAIT_V
#undef PG8_WAIT_L
#undef PG8_BAR
#undef PG8_SCHED
}
}

struct P {
    const float *x, *c, *ctx, *c_ctx, *ada_w, *ada_b, *pre_g, *post_g, *ffn_up, *ffn_conv, *ffn_down, *ab_w_in, *ab_qk_conv, *ab_gate_b, *ab_sgu_w, *ab_sgu_b,
                *ab_head_g, *ab_w_out, *ret_w_in, *ret_decay, *ret_head_g, *ret_w_out;
    float* out; unsigned char* ws;
};

constexpr int MC_S = 136;
constexpr int MC_OFF_V = 0, MC_OFF_RT = MC_OFF_V + 144 * MC_S * 2, MC_OFF_K = MC_OFF_RT + 144 * MC_S * 2;
static_assert(MC_OFF_K + 128 * MC_S * 2 <= LDS_BYTES - 64, "mlstm chunk LDS");
__device__ __forceinline__ void mlstm_chunk_item(const P& p, LAS unsigned char* lds, int bl, int h, int dir, const int tid0) {
    const int wave = __builtin_amdgcn_readfirstlane(tid0 >> 6);
    const bf16_t* QC = (const bf16_t*)(p.ws + OFF_QC); const bf16_t* KC = (const bf16_t*)(p.ws + OFF_KC); const bf16_t* VT = (const bf16_t*)(p.ws + OFF_VT0);
    bf16_t* RO = (bf16_t*)(p.ws + (dir ? OFF_RB : OFF_RF));
    const float* ROWT = (const float*)(p.ws + OFF_ROWT); const float* COLT = (const float*)(p.ws + OFF_COLT); const float* ENM = (const float*)(p.ws + OFF_ENM);
    LAS bf16_t* Vs = (LAS bf16_t*)(lds + MC_OFF_V); LAS bf16_t* RT = (LAS bf16_t*)(lds + MC_OFF_RT); LAS bf16_t* Ks = (LAS bf16_t*)(lds + MC_OFF_K);
    const size_t rowbase = (size_t)bl * LT;
    const size_t sbase = (size_t)((bl * 4 + h) * 2 + dir) * LT;
    f32x4 st[9];
#pragma unroll
    for (int mt = 0; mt < 9; ++mt) st[mt] = (f32x4){0.f, 0.f, 0.f, 0.f};
    __syncthreads();
    for (int idx = tid0; idx < 15 * MC_S / 2; idx += 512) ((LAS unsigned*)(Vs + 129 * MC_S))[idx] = 0u;
#define MC_J(pp) (dir == 0 ? (pp) : ((pp) < 256 ? 255 - (pp) : 2559 - (pp)))
#define MC_CJ(sx) (dir == 0 ? (sx) : ((sx) < 2 ? 1 - (sx) : 19 - (sx)))
    u32x4 pv[4], pk[4]; f32x4 cz[2]; bf16x8 qf[4];
    {
        int t0 = tid0; asm volatile("" : "+v"(t0)); const int tid = t0, lane = tid & 63, l15 = lane & 15, quad = lane >> 4, vpart = tid & 15;
        const int cj = MC_CJ(0); const size_t tok0 = rowbase + (size_t)cj * 128;
        const char* vbase = (const char*)(VT + (size_t)(h * 128) * TG + tok0);
        const unsigned voff = (unsigned)(tid >> 4) * (unsigned)(TG * 2) + (unsigned)vpart * 16u;
        const char* kbase = (const char*)(KC + tok0 * 512 + h * 128);
        const unsigned koff = (unsigned)(((tid >> 4) * 512 + vpart * 8) * 2);
#pragma unroll
        for (int i = 0; i < 4; ++i) pv[i] = *(const u32x4*)(vbase + (size_t)i * 32 * TG * 2 + voff);
#pragma unroll
        for (int i = 0; i < 4; ++i) pk[i] = *(const u32x4*)(kbase + (size_t)i * 32 * 512 * 2 + koff);
        cz[0] = *(const f32x4*)(COLT + sbase + cj * 128 + vpart * 8); cz[1] = *(const f32x4*)(COLT + sbase + cj * 128 + vpart * 8 + 4);
#pragma unroll
        for (int ks = 0; ks < 4; ++ks) qf[ks] = *(const bf16x8*)((const char*)(QC + tok0 * 512 + h * 128) + (unsigned)(((wave * 16 + l15) * 512 + quad * 8) * 2) + ks * 64);
    }
#pragma unroll 1
    for (int sidx = 0; sidx < 18; ++sidx) {
        const int cj = MC_CJ(sidx);
        const size_t tok0 = rowbase + (size_t)cj * 128;
        int tl = tid0; asm volatile("" : "+v"(tl));
        const int tid = tl, lane = tid & 63, l15 = lane & 15, quad = lane >> 4, vpart = tid & 15;
        const float Rend = ROWT[sbase + MC_J(128 * sidx + 127)];
        const float Rprev = sidx ? ROWT[sbase + MC_J(128 * sidx - 1)] : Rend;
        const int qpos = wave * 16 + l15;
        const float rtq = ROWT[sbase + cj * 128 + qpos];
        const float enq = ENM[sbase + cj * 128 + qpos];
        __syncthreads();
        {
            float zf[8];
            zf[0] = fast_exp2(cz[0][0] + Rend); zf[1] = fast_exp2(cz[0][1] + Rend); zf[2] = fast_exp2(cz[0][2] + Rend); zf[3] = fast_exp2(cz[0][3] + Rend);
            zf[4] = fast_exp2(cz[1][0] + Rend); zf[5] = fast_exp2(cz[1][1] + Rend); zf[6] = fast_exp2(cz[1][2] + Rend); zf[7] = fast_exp2(cz[1][3] + Rend);
#pragma unroll
            for (int i = 0; i < 4; ++i) {
                float f[8]; unpack8(pv[i], f);
                u32x4 w; w.x = pk2(f[0] * zf[0], f[1] * zf[1]); w.y = pk2(f[2] * zf[2], f[3] * zf[3]); w.z = pk2(f[4] * zf[4], f[5] * zf[5]); w.w = pk2(f[6] * zf[6], f[7] * zf[7]);
                *(LAS u32x4*)(Vs + ((tid >> 4) + 32 * i) * MC_S + vpart * 8) = w;
            }
            if (tid < 16) { u32x4 w; w.x = pk2(zf[0], zf[1]); w.y = pk2(zf[2], zf[3]); w.z = pk2(zf[4], zf[5]); w.w = pk2(zf[6], zf[7]); *(LAS u32x4*)(Vs + 128 * MC_S + vpart * 8) = w; }
#pragma unroll
            for (int i = 0; i < 4; ++i) *(LAS u32x4*)(Ks + ((tid >> 4) + 32 * i) * MC_S + vpart * 8) = pk[i];
        }
        const float rfq = fast_exp2(rtq - Rend);
        __syncthreads();
        f32x4 o[9];
        if (sidx) {
#pragma unroll
            for (int nt = 0; nt < 9; ++nt) {
                f32x4 acc = (f32x4){0.f, 0.f, 0.f, 0.f};
#pragma unroll
                for (int ks = 0; ks < 4; ++ks) { const bf16x8 b = *(const LAS bf16x8*)(RT + (nt * 16 + l15) * MC_S + ks * 32 + quad * 8);
                    acc = __builtin_amdgcn_mfma_f32_16x16x32_bf16(qf[ks], b, acc, 0, 0, 0); }
                o[nt] = acc;
            }
            const f32x4 rt4 = *(const f32x4*)(ROWT + sbase + cj * 128 + wave * 16 + quad * 4);
#pragma unroll
            for (int r = 0; r < 4; ++r) { const float cf = fast_exp2(rt4[r] - Rprev);
#pragma unroll
                for (int nt = 0; nt < 9; ++nt) o[nt][r] *= cf; }
        } else {
#pragma unroll
            for (int nt = 0; nt < 9; ++nt) o[nt] = (f32x4){0.f, 0.f, 0.f, 0.f};
        }
        f32x4 sT[8];
#pragma unroll
        for (int kt = 0; kt < 8; ++kt) {
            f32x4 sa = (f32x4){0.f, 0.f, 0.f, 0.f};
#pragma unroll
            for (int ks = 0; ks < 4; ++ks) { const bf16x8 a = *(const LAS bf16x8*)(Ks + (kt * 16 + l15) * MC_S + ks * 32 + quad * 8);
                sa = __builtin_amdgcn_mfma_f32_16x16x32_bf16(a, qf[ks], sa, 0, 0, 0); }
#pragma unroll
            for (int r = 0; r < 4; ++r) { const int kpos = kt * 16 + quad * 4 + r; const bool ok = dir ? (kpos >= qpos) : (kpos <= qpos); sa[r] = ok ? sa[r] * rfq : 0.f; }
            sT[kt] = sa;
        }
        if (sidx + 1 < 18) {
            const size_t tokn = rowbase + (size_t)MC_CJ(sidx + 1) * 128;
#pragma unroll
            for (int ks = 0; ks < 4; ++ks) qf[ks] = *(const bf16x8*)((const char*)(QC + tokn * 512 + h * 128) + (unsigned)((qpos * 512 + quad * 8) * 2) + ks * 64);
        }
#pragma unroll
        for (int i = 0; i < 4; ++i) {
            u32x4 pw; pw.x = cvt_pk_bf16(sT[2 * i][0], sT[2 * i][1]); pw.y = cvt_pk_bf16(sT[2 * i][2], sT[2 * i][3]);
            pw.z = cvt_pk_bf16(sT[2 * i + 1][0], sT[2 * i + 1][1]); pw.w = cvt_pk_bf16(sT[2 * i + 1][2], sT[2 * i + 1][3]);
            const bf16x8 pa = __builtin_bit_cast(bf16x8, pw);
#pragma unroll
            for (int nt = 0; nt < 9; ++nt) {
                const u32x2 lo = *(const LAS u32x2*)(Vs + (nt * 16 + l15) * MC_S + i * 32 + quad * 4);
                const u32x2 hi = *(const LAS u32x2*)(Vs + (nt * 16 + l15) * MC_S + i * 32 + 16 + quad * 4);
                u32x4 bw; bw.x = lo.x; bw.y = lo.y; bw.z = hi.x; bw.w = hi.y;
                o[nt] = __builtin_amdgcn_mfma_f32_16x16x32_bf16(pa, __builtin_bit_cast(bf16x8, bw), o[nt], 0, 0, 0);
            }
        }
        {
            const f32x4 en4 = *(const f32x4*)(ENM + sbase + cj * 128 + wave * 16 + quad * 4);
#pragma unroll
            for (int r = 0; r < 4; ++r) {
                const float den = shfl_idx(o[8][r], quad * 16);
                const float inv = 1.0f / fmaxf(fabsf(den), en4[r]);
                bf16_t* orow = (bf16_t*)((char*)(RO + tok0 * 512 + h * 128) + (unsigned)(((wave * 16 + quad * 4 + r) * 512 + l15) * 2));
#pragma unroll
                for (int nt = 0; nt < 8; ++nt) orow[nt * 16] = (bf16_t)f2bf(o[nt][r] * inv);
            }
        }
        (void)enq;
        __syncthreads();
        if (sidx + 1 < 18) {
            const int cjn = MC_CJ(sidx + 1); const size_t tokn = rowbase + (size_t)cjn * 128;
            const char* vbase = (const char*)(VT + (size_t)(h * 128) * TG + tokn);
            const unsigned voff = (unsigned)(tid >> 4) * (unsigned)(TG * 2) + (unsigned)vpart * 16u;
            const char* kbase = (const char*)(KC + tokn * 512 + h * 128);
            const unsigned koff = (unsigned)(((tid >> 4) * 512 + vpart * 8) * 2);
#pragma unroll
            for (int i = 0; i < 4; ++i) pv[i] = *(const u32x4*)(vbase + (size_t)i * 32 * TG * 2 + voff);
#pragma unroll
            for (int i = 0; i < 4; ++i) pk[i] = *(const u32x4*)(kbase + (size_t)i * 32 * 512 * 2 + koff);
            cz[0] = *(const f32x4*)(COLT + sbase + cjn * 128 + vpart * 8); cz[1] = *(const f32x4*)(COLT + sbase + cjn * 128 + vpart * 8 + 4);
        }
        {
            const float decay = fast_exp2(Rend - Rprev);
#pragma unroll
            for (int mt = 0; mt < 9; ++mt) st[mt] = st[mt] * decay;
#pragma unroll
            for (int ks = 0; ks < 4; ++ks) {
                u32x4 bw;
                { const LAS bf16_t* kp = Ks + (ks * 32 + quad * 8) * MC_S + wave * 16 + l15;
                  bw.x = (unsigned)kp[0 * MC_S] | ((unsigned)kp[1 * MC_S] << 16); bw.y = (unsigned)kp[2 * MC_S] | ((unsigned)kp[3 * MC_S] << 16);
                  bw.z = (unsigned)kp[4 * MC_S] | ((unsigned)kp[5 * MC_S] << 16); bw.w = (unsigned)kp[6 * MC_S] | ((unsigned)kp[7 * MC_S] << 16); }
                const bf16x8 b = __builtin_bit_cast(bf16x8, bw);
#pragma unroll
                for (int mt = 0; mt < 9; ++mt) { const bf16x8 a = *(const LAS bf16x8*)(Vs + (mt * 16 + l15) * MC_S + ks * 32 + quad * 8);
                    st[mt] = __builtin_amdgcn_mfma_f32_16x16x32_bf16(a, b, st[mt], 0, 0, 0); }
            }
#pragma unroll
            for (int mt = 0; mt < 9; ++mt)
#pragma unroll
                for (int r = 0; r < 4; ++r) RT[(mt * 16 + quad * 4 + r) * MC_S + wave * 16 + l15] = (bf16_t)f2bf(st[mt][r]);
        }
    }
#undef MC_CJ
#undef MC_J
}
__device__ __forceinline__ void mlstm_post_row(const P& p, int r, int lane) {
    const bf16_t* RF = (const bf16_t*)(p.ws + OFF_RF) + (size_t)r * 512; const bf16_t* RB = (const bf16_t*)(p.ws + OFF_RB) + (size_t)r * 512;
    const bf16_t* OG = (const bf16_t*)(p.ws + OFF_PN) + (size_t)r * 2048 + 1024;
    bf16_t* CAT = (bf16_t*)(p.ws + OFF_H) + (size_t)r * 1024 + 512;
    const int c0 = lane * 8;
    float a[8], b[8], g[8]; unpack8(__builtin_nontemporal_load((const u32x4*)(RF + c0)), a); unpack8(__builtin_nontemporal_load((const u32x4*)(RB + c0)), b); unpack8(__builtin_nontemporal_load((const u32x4*)(OG + c0)), g);
    float s = 0.f;
#pragma unroll
    for (int i = 0; i < 8; ++i) { a[i] = (a[i] + b[i]) * g[i]; s += a[i]; }
    s += shfl_xor_l(s, 1, lane); s += shfl_xor_l(s, 2, lane); s += shfl_xor_l(s, 4, lane); s += shfl_xor_l(s, 8, lane);
    const float mean = s * (1.0f / 128.0f); float q = 0.f;
#pragma unroll
    for (int i = 0; i < 8; ++i) { a[i] -= mean; q += a[i] * a[i]; }
    q += shfl_xor_l(q, 1, lane); q += shfl_xor_l(q, 2, lane); q += shfl_xor_l(q, 4, lane); q += shfl_xor_l(q, 8, lane);
    const float rstd = rsqrtf(q * (1.0f / 128.0f) + 1e-6f);
    const f32x4 h0 = *(const f32x4*)(p.ab_head_g + c0), h1 = *(const f32x4*)(p.ab_head_g + c0 + 4);
    u32x4 w; w.x = pk2(a[0] * rstd * h0[0], a[1] * rstd * h0[1]); w.y = pk2(a[2] * rstd * h0[2], a[3] * rstd * h0[3]);
    w.z = pk2(a[4] * rstd * h1[0], a[5] * rstd * h1[1]); w.w = pk2(a[6] * rstd * h1[2], a[7] * rstd * h1[3]);
    *(u32x4*)(CAT + c0) = w;
}

__device__ __forceinline__ void sgu_item(const P& p, int bl, int chunk, int g, const int tid) {
    const int wave = __builtin_amdgcn_readfirstlane(tid >> 6), lane = tid & 63, l15 = lane & 15, quad = lane >> 4;
    const bf16_t* SW = (const bf16_t*)(p.ws + OFF_SGUW); const bf16_t* VT = (const bf16_t*)(p.ws + OFF_VT0);
    const bf16_t* PN = (const bf16_t*)(p.ws + OFF_PN); bf16_t* CAT = (bf16_t*)(p.ws + OFF_H);
    const size_t tok0 = (size_t)bl * LT + chunk * 128;
    bf16x8 af[4];
#pragma unroll
    for (int ks = 0; ks < 4; ++ks) af[ks] = *(const bf16x8*)(SW + (size_t)(g * 128 + wave * 16 + l15) * 128 + ks * 32 + quad * 8);
#pragma unroll 2
    for (int nt = 0; nt < 8; ++nt) {
        f32x4 acc = (f32x4){0.f, 0.f, 0.f, 0.f};
#pragma unroll
        for (int ks = 0; ks < 4; ++ks) {
            const bf16x8 b = *(const bf16x8*)(VT + (size_t)(512 + g * 128 + nt * 16 + l15) * TG + tok0 + ks * 32 + quad * 8);
            acc = __builtin_amdgcn_mfma_f32_16x16x32_bf16(af[ks], b, acc, 0, 0, 0);
        }
#pragma unroll
        for (int r = 0; r < 4; ++r) {
            const int pp = wave * 16 + quad * 4 + r; const size_t tok = tok0 + pp;
            const float uu = bf2f(PN[tok * 2048 + 1536 + g * 128 + nt * 16 + l15]);
            CAT[tok * 1024 + g * 128 + nt * 16 + l15] = (bf16_t)f2bf((acc[r] + p.ab_sgu_b[g * 128 + pp]) * uu);
        }
    }
}

constexpr int RC_VS = 136, RC_RS = 264, RC_KS = 264, RC_KTS = 136;
constexpr int RC_OFF_V = 0, RC_OFF_RT = RC_OFF_V + 128 * RC_VS * 2, RC_OFF_KT = RC_OFF_RT, RC_OFF_KH = RC_OFF_KT + 256 * RC_KTS * 2;
static_assert(RC_OFF_KH + 64 * RC_KS * 2 <= LDS_BYTES - 64, "retention LDS");
static_assert(RC_OFF_RT + 128 * RC_RS * 2 <= RC_OFF_KH, "retention LDS overlay");
__device__ __forceinline__ void ret_chunk_item(const P& p, LAS unsigned char* lds, int bl, int h, int vs, const int tid) {
    const int wave = __builtin_amdgcn_readfirstlane(tid >> 6), lane = tid & 63, l15 = lane & 15, quad = lane >> 4;
    const bf16_t* Q1 = (const bf16_t*)(p.ws + OFF_Q1); const bf16_t* K1 = (const bf16_t*)(p.ws + OFF_K1); const bf16_t* VT = (const bf16_t*)(p.ws + OFF_VT1);
    const bf16_t* K1T = (const bf16_t*)(p.ws + OFF_K1T);
    LAS bf16_t* Vs = (LAS bf16_t*)(lds + RC_OFF_V); LAS bf16_t* RT = (LAS bf16_t*)(lds + RC_OFF_RT);
    LAS bf16_t* KTs = (LAS bf16_t*)(lds + RC_OFF_KT); LAS bf16_t* KH = (LAS bf16_t*)(lds + RC_OFF_KH);
    const size_t rowbase = (size_t)bl * LT;
#define RC_CJ(sx) (dir == 0 ? (sx) : ((sx) < 2 ? 1 - (sx) : 19 - (sx)))
#pragma unroll 1
    for (int dir = 0; dir < 2; ++dir) {
        bf16_t* RO = (bf16_t*)(p.ws + (dir ? OFF_MRG2 : OFF_MRG));
        const float dl = p.ret_decay[dir * 4 + h];
        const float lg2 = logsig(dl) * LOG2E;
        const float g128 = fast_exp2(lg2 * 128.0f);
        f32x4 st[2][8];
#pragma unroll
        for (int mt = 0; mt < 2; ++mt)
#pragma unroll
            for (int nt = 0; nt < 8; ++nt) st[mt][nt] = (f32x4){0.f, 0.f, 0.f, 0.f};
        u32x4 pv[4], pk[4]; bf16x8 qf[8];
        {
            int t0 = tid; asm volatile("" : "+v"(t0)); const int tid = t0;
            const size_t tok0 = rowbase + (size_t)RC_CJ(0) * 128;
            const u32x4* vp = (const u32x4*)((const char*)(VT + (size_t)(h * 512 + vs * 128) * TG + tok0) + ((unsigned)(tid >> 2) * (unsigned)(TG * 2) + (unsigned)(tid & 3) * 64u));
            const u32x4* kp = (const u32x4*)((const char*)(K1 + tok0 * 1024 + h * 256) + (unsigned)(((tid >> 3) * 1024 + (tid & 7) * 32) * 2));
#pragma unroll
            for (int i = 0; i < 4; ++i) pv[i] = vp[i];
#pragma unroll
            for (int i = 0; i < 4; ++i) pk[i] = kp[i];
        }
#pragma unroll 1
        for (int sidx = 0; sidx < 18; ++sidx) {
            const int cj = RC_CJ(sidx);
            const bool is_lat = cj >= 2;
            const size_t tok0 = rowbase + (size_t)cj * 128;
            int tl = tid; asm volatile("" : "+v"(tl));
            const int tid = tl, lane = tid & 63, l15 = lane & 15, quad = lane >> 4, vpart = tid & 15;
            const unsigned ktoff = (unsigned)(tid >> 2) * (unsigned)(TG * 2) + (unsigned)(tid & 3) * 64u;
            const unsigned khoff = (unsigned)(((tid >> 3) * 1024 + (tid & 7) * 32) * 2);
            const int qpos = wave * 16 + l15;
            __syncthreads();
            {
                const int p0 = (tid & 3) * 32;
                float z = fast_exp2(lg2 * (float)(dir ? p0 : 127 - p0));
                const float zstep = fast_exp2(dir ? lg2 : -lg2);
#pragma unroll
                for (int i = 0; i < 4; ++i) {
                    float f[8]; unpack8(pv[i], f);
#pragma unroll
                    for (int e = 0; e < 8; ++e) { f[e] *= z; z *= zstep; }
                    u32x4 w; w.x = pk2(f[0], f[1]); w.y = pk2(f[2], f[3]); w.z = pk2(f[4], f[5]); w.w = pk2(f[6], f[7]);
                    *(LAS u32x4*)(Vs + (tid >> 2) * RC_VS + p0 + i * 8) = w;
                }
#pragma unroll
                for (int i = 0; i < 4; ++i) *(LAS u32x4*)(KH + (tid >> 3) * RC_KS + (tid & 7) * 32 + i * 8) = pk[i];
            }
            __syncthreads();
            f32x4 o[8];
#pragma unroll 1
            for (int hf = 0; hf < 2; ++hf) {
                if (hf == 0) {
#pragma unroll
                    for (int i = 0; i < 4; ++i) pk[i] = ((const u32x4*)((const char*)(K1 + (tok0 + 64) * 1024 + h * 256) + khoff))[i];
                } else {
                    __syncthreads();
#pragma unroll
                    for (int i = 0; i < 4; ++i) *(LAS u32x4*)(KH + (tid >> 3) * RC_KS + (tid & 7) * 32 + i * 8) = pk[i];
                    __syncthreads();
                    if (sidx + 1 < 18) {
                        const size_t tokn = rowbase + (size_t)RC_CJ(sidx + 1) * 128;
#pragma unroll
                        for (int i = 0; i < 4; ++i) pk[i] = ((const u32x4*)((const char*)(K1 + tokn * 1024 + h * 256) + khoff))[i];
                    }
                }
                if (is_lat) {
                    if (hf == 0) {
#pragma unroll
                        for (int nt = 0; nt < 8; ++nt) {
                            f32x4 acc = (f32x4){0.f, 0.f, 0.f, 0.f};
#pragma unroll
                            for (int ks = 0; ks < 8; ++ks) { const bf16x8 b = *(const LAS bf16x8*)(RT + (nt * 16 + l15) * RC_RS + ks * 32 + quad * 8);
                                acc = __builtin_amdgcn_mfma_f32_16x16x32_bf16(qf[ks], b, acc, 0, 0, 0); }
#pragma unroll
                            for (int r = 0; r < 4; ++r) { const int pos = wave * 16 + quad * 4 + r; acc[r] *= fast_exp2(lg2 * (float)((dir ? 127 - pos : pos) + 1)); }
                            o[nt] = acc;
                            __builtin_amdgcn_sched_barrier(0);
                        }
                    }
                    f32x4 sT[4];
#pragma unroll
                    for (int kt = 0; kt < 4; ++kt) {
                        f32x4 sa = (f32x4){0.f, 0.f, 0.f, 0.f};
#pragma unroll
                        for (int ks = 0; ks < 8; ++ks) { const bf16x8 a = *(const LAS bf16x8*)(KH + (kt * 16 + l15) * RC_KS + ks * 32 + quad * 8);
                            sa = __builtin_amdgcn_mfma_f32_16x16x32_bf16(a, qf[ks], sa, 0, 0, 0); }
                        sT[kt] = sa;
                        __builtin_amdgcn_sched_barrier(0);
                    }
                    if (hf == 1 && sidx + 1 < 18 && RC_CJ(sidx + 1) >= 2) {
                        const size_t tokn = rowbase + (size_t)RC_CJ(sidx + 1) * 128;
#pragma unroll
                        for (int ks = 0; ks < 8; ++ks) qf[ks] = *(const bf16x8*)((const char*)(Q1 + tokn * 1024 + h * 256) + (unsigned)((qpos * 1024 + quad * 8) * 2) + ks * 64);
                    }
                    const float rsq = fast_exp2(lg2 * (float)((dir ? 127 - qpos : qpos) - 127));
#pragma unroll
                    for (int kt = 0; kt < 4; ++kt)
#pragma unroll
                        for (int r = 0; r < 4; ++r) { const int kpos = hf * 64 + kt * 16 + quad * 4 + r;
                            const bool ok = dir ? (kpos >= qpos) : (kpos <= qpos);
                            sT[kt][r] = ok ? sT[kt][r] * rsq : 0.f; }
#pragma unroll
                    for (int i = 0; i < 2; ++i) {
                        u32x4 pw; pw.x = cvt_pk_bf16(sT[2 * i][0], sT[2 * i][1]); pw.y = cvt_pk_bf16(sT[2 * i][2], sT[2 * i][3]);
                        pw.z = cvt_pk_bf16(sT[2 * i + 1][0], sT[2 * i + 1][1]); pw.w = cvt_pk_bf16(sT[2 * i + 1][2], sT[2 * i + 1][3]);
                        const bf16x8 pa = __builtin_bit_cast(bf16x8, pw);
#pragma unroll
                        for (int nt = 0; nt < 8; ++nt) {
                            const u32x2 lo = *(const LAS u32x2*)(Vs + (nt * 16 + l15) * RC_VS + hf * 64 + i * 32 + quad * 4);
                            const u32x2 hi = *(const LAS u32x2*)(Vs + (nt * 16 + l15) * RC_VS + hf * 64 + i * 32 + 16 + quad * 4);
                            u32x4 bw; bw.x = lo.x; bw.y = lo.y; bw.z = hi.x; bw.w = hi.y;
                            o[nt] = __builtin_amdgcn_mfma_f32_16x16x32_bf16(pa, __builtin_bit_cast(bf16x8, bw), o[nt], 0, 0, 0);
                        }
                    }
                    if (hf == 1) {
#pragma unroll
                        for (int r = 0; r < 4; ++r) {
                            bf16_t* orow = (bf16_t*)((char*)(RO + ((size_t)bl * SEQ + (cj - 2) * 128) * 2048 + h * 512 + vs * 128) + (unsigned)(((wave * 16 + quad * 4 + r) * 2048 + l15) * 2));
#pragma unroll
                            for (int nt = 0; nt < 8; ++nt) orow[nt * 16] = (bf16_t)f2bf(o[nt][r]);
                        }
                    }
                } else if (hf == 1 && sidx + 1 < 18 && RC_CJ(sidx + 1) >= 2) {
                    const size_t tokn = rowbase + (size_t)RC_CJ(sidx + 1) * 128;
#pragma unroll
                    for (int ks = 0; ks < 8; ++ks) qf[ks] = *(const bf16x8*)((const char*)(Q1 + tokn * 1024 + h * 256) + (unsigned)((qpos * 1024 + quad * 8) * 2) + ks * 64);
                }
                if (hf == 1 && sidx + 1 < 18) {
                    const size_t tokn = rowbase + (size_t)RC_CJ(sidx + 1) * 128;
                    const char* vbase = (const char*)(VT + (size_t)(h * 512 + vs * 128) * TG + tokn);
#pragma unroll
                    for (int i = 0; i < 4; ++i) pv[i] = ((const u32x4*)(vbase + ktoff))[i];
                }
                if (hf == 0) {
#pragma unroll
                    for (int mt = 0; mt < 2; ++mt)
#pragma unroll
                        for (int nt = 0; nt < 8; ++nt) st[mt][nt] = st[mt][nt] * g128;
                }
#pragma unroll
                for (int ks2 = 0; ks2 < 2; ++ks2) {
#pragma unroll
                    for (int mt = 0; mt < 2; ++mt) {
                        u32x4 aw;
                        { const LAS bf16_t* kp = KH + (ks2 * 32 + quad * 8) * RC_KS + wave * 32 + mt * 16 + l15;
                          aw.x = (unsigned)kp[0 * RC_KS] | ((unsigned)kp[1 * RC_KS] << 16); aw.y = (unsigned)kp[2 * RC_KS] | ((unsigned)kp[3 * RC_KS] << 16);
                          aw.z = (unsigned)kp[4 * RC_KS] | ((unsigned)kp[5 * RC_KS] << 16); aw.w = (unsigned)kp[6 * RC_KS] | ((unsigned)kp[7 * RC_KS] << 16); }
                        const bf16x8 a = __builtin_bit_cast(bf16x8, aw);
#pragma unroll
                        for (int nt = 0; nt < 8; ++nt) { const bf16x8 b = *(const LAS bf16x8*)(Vs + (nt * 16 + l15) * RC_VS + hf * 64 + ks2 * 32 + quad * 8);
                            st[mt][nt] = __builtin_amdgcn_mfma_f32_16x16x32_bf16(a, b, st[mt][nt], 0, 0, 0); }
                        __builtin_amdgcn_sched_barrier(0);
                    }
                }
            }
#pragma unroll
            for (int mt = 0; mt < 2; ++mt)
#pragma unroll
                for (int nt = 0; nt < 8; ++nt) { u32x2 w; w.x = cvt_pk_bf16(st[mt][nt][0], st[mt][nt][1]); w.y = cvt_pk_bf16(st[mt][nt][2], st[mt][nt][3]);
                    *(LAS u32x2*)(RT + (nt * 16 + l15) * RC_RS + wave * 32 + mt * 16 + quad * 4) = w; }
        }
    }
#undef RC_CJ
}
__device__ __forceinline__ void ret_post_row(const P& p, int rl, int lane) {
    bf16_t* row = (bf16_t*)(p.ws + OFF_MRG) + (size_t)rl * 2048;
    const bf16_t* row2 = (const bf16_t*)(p.ws + OFF_MRG2) + (size_t)rl * 2048;
    const int bl = rl / SEQ, t = rl % SEQ;
    const bf16_t* grow = (const bf16_t*)(p.ws + OFF_G1) + ((size_t)bl * LT + 256 + t) * 2048;
#pragma unroll
    for (int hh = 0; hh < 4; ++hh) {
        const int c0 = hh * 512 + lane * 8;
        const f32x4 h0 = *(const f32x4*)(p.ret_head_g + c0), h1 = *(const f32x4*)(p.ret_head_g + c0 + 4);
        float v[2][8], gv[2][8];
#pragma unroll
        for (int q = 0; q < 2; ++q) {
            float v2[8]; unpack8(__builtin_nontemporal_load((const u32x4*)(row + q * 2048 + c0)), v[q]); unpack8(__builtin_nontemporal_load((const u32x4*)(row2 + q * 2048 + c0)), v2);
            unpack8(__builtin_nontemporal_load((const u32x4*)(grow + q * 2048 + c0)), gv[q]);
#pragma unroll
            for (int i = 0; i < 8; ++i) v[q][i] += v2[i];
        }
#pragma unroll
        for (int q = 0; q < 2; ++q) {
            float s = 0.f;
#pragma unroll
            for (int i = 0; i < 8; ++i) s += v[q][i];
            const float mean = wave_sum(s, lane) * (1.0f / 512.0f);
            float qq = 0.f;
#pragma unroll
            for (int i = 0; i < 8; ++i) { v[q][i] -= mean; qq += v[q][i] * v[q][i]; }
            const float rstd = rsqrtf(wave_sum(qq, lane) * (1.0f / 512.0f) + 1e-6f);
            u32x4 w; w.x = pk2(v[q][0] * rstd * h0[0] * gv[q][0], v[q][1] * rstd * h0[1] * gv[q][1]); w.y = pk2(v[q][2] * rstd * h0[2] * gv[q][2], v[q][3] * rstd * h0[3] * gv[q][3]);
            w.z = pk2(v[q][4] * rstd * h1[0] * gv[q][4], v[q][5] * rstd * h1[1] * gv[q][5]); w.w = pk2(v[q][6] * rstd * h1[2] * gv[q][6], v[q][7] * rstd * h1[3] * gv[q][7]);
            *(u32x4*)(row + q * 2048 + c0) = w;
        }
    }
}

template <bool GATES>
__device__ __forceinline__ void row_pass(const float* xsrc, const bf16_t* y, float* xdst, bf16_t* hrow, const float* postg, const float* mg,
                                         const float* preg, const float* msh, const float* msc, int lane,
                                         const LAS float* wgT = nullptr, const float* gate_b = nullptr, float* grow = nullptr) {
    f32x4 v[4];
#pragma unroll
    for (int j = 0; j < 4; ++j) v[j] = __builtin_nontemporal_load((const f32x4*)(xsrc + lane * 4 + 256 * j));
    if (y) {
        f32x4 yv[4]; float ss = 0.f;
#pragma unroll
        for (int j = 0; j < 4; ++j) { const u32x2 w = __builtin_nontemporal_load((const u32x2*)(y + lane * 4 + 256 * j)); yv[j] = (f32x4){bflo(w.x), bfhi(w.x), bflo(w.y), bfhi(w.y)};
            ss += (yv[j][0] * yv[j][0] + yv[j][1] * yv[j][1]) + (yv[j][2] * yv[j][2] + yv[j][3] * yv[j][3]); }
        ss = wave_sum(ss, lane);
        const float ry = rsqrtf(ss * (1.0f / 1024.0f) + 1e-6f);
#pragma unroll
        for (int j = 0; j < 4; ++j) { const f32x4 pg = *(const f32x4*)(postg + lane * 4 + 256 * j), gg = *(const f32x4*)(mg + lane * 4 + 256 * j);
            v[j] = v[j] + gg * (yv[j] * ry * pg); }
        if (xdst) {
#pragma unroll
            for (int j = 0; j < 4; ++j) __builtin_nontemporal_store(v[j], (f32x4*)(xdst + lane * 4 + 256 * j));
        }
    }
    if (hrow) {
        float ss = 0.f;
#pragma unroll
        for (int j = 0; j < 4; ++j) ss += (v[j][0] * v[j][0] + v[j][1] * v[j][1]) + (v[j][2] * v[j][2] + v[j][3] * v[j][3]);
        ss = wave_sum(ss, lane);
        const float rx = rsqrtf(ss * (1.0f / 1024.0f) + 1e-6f);
#pragma unroll
        for (int j = 0; j < 4; ++j) { const f32x4 pr = *(const f32x4*)(preg + lane * 4 + 256 * j), sh = *(const f32x4*)(msh + lane * 4 + 256 * j), sc = *(const f32x4*)(msc + lane * 4 + 256 * j);
            const f32x4 hv = v[j] * rx * pr * (sc + 1.0f) + sh;
            if (GATES) v[j] = hv;
            u32x2 w; w.x = pk2(hv[0], hv[1]); w.y = pk2(hv[2], hv[3]);
            __builtin_nontemporal_store(w, (u32x2*)(hrow + lane * 4 + 256 * j)); }
        if (GATES) {
            float mine = 0.f;
#pragma unroll 2
            for (int g = 0; g < 16; ++g) {
                float s = 0.f;
#pragma unroll
                for (int j = 0; j < 4; ++j) { const f32x4 w = *(const LAS f32x4*)(wgT + g * 1024 + lane * 4 + 256 * j);
                    s += (v[j][0] * w[0] + v[j][1] * w[1]) + (v[j][2] * w[2] + v[j][3] * w[3]); }
                s = wave_sum(s, lane);
                if (lane == g) mine = s;
            }
            if (lane < 16) grow[lane] = mine + gate_b[lane];
        }
    }
}

template <bool GATES>
__device__ __forceinline__ void row_pass2(const float* xsrc, const bf16_t* y, float* xdst, bf16_t* hrow, const float* postg, const float* mg,
                                          const float* preg, const float* msh, const float* msc, int lane,
                                          const LAS float* wgT = nullptr, const float* gate_b = nullptr, float* grow = nullptr) {
    f32x4 v[2][4];
#pragma unroll
    for (int q = 0; q < 2; ++q)
#pragma unroll
        for (int j = 0; j < 4; ++j) v[q][j] = __builtin_nontemporal_load((const f32x4*)(xsrc + q * 1024 + lane * 4 + 256 * j));
    if (y) {
        f32x4 yv[2][4]; float ss[2] = {0.f, 0.f};
#pragma unroll
        for (int q = 0; q < 2; ++q)
#pragma unroll
            for (int j = 0; j < 4; ++j) { const u32x2 w = __builtin_nontemporal_load((const u32x2*)(y + q * 1024 + lane * 4 + 256 * j)); yv[q][j] = (f32x4){bflo(w.x), bfhi(w.x), bflo(w.y), bfhi(w.y)};
                ss[q] += (yv[q][j][0] * yv[q][j][0] + yv[q][j][1] * yv[q][j][1]) + (yv[q][j][2] * yv[q][j][2] + yv[q][j][3] * yv[q][j][3]); }
        ss[0] = wave_sum(ss[0], lane); ss[1] = wave_sum(ss[1], lane);
        const float ry0 = rsqrtf(ss[0] * (1.0f / 1024.0f) + 1e-6f), ry1 = rsqrtf(ss[1] * (1.0f / 1024.0f) + 1e-6f);
#pragma unroll
        for (int j = 0; j < 4; ++j) { const f32x4 pg = *(const f32x4*)(postg + lane * 4 + 256 * j), gg = *(const f32x4*)(mg + lane * 4 + 256 * j);
            v[0][j] = v[0][j] + gg * (yv[0][j] * ry0 * pg); v[1][j] = v[1][j] + gg * (yv[1][j] * ry1 * pg); }
        if (xdst) {
#pragma unroll
            for (int q = 0; q < 2; ++q)
#pragma unroll
                for (int j = 0; j < 4; ++j) __builtin_nontemporal_store(v[q][j], (f32x4*)(xdst + q * 1024 + lane * 4 + 256 * j));
        }
    }
    if (hrow) {
        float ss[2] = {0.f, 0.f};
#pragma unroll
        for (int q = 0; q < 2; ++q)
#pragma unroll
            for (int j = 0; j < 4; ++j) ss[q] += (v[q][j][0] * v[q][j][0] + v[q][j][1] * v[q][j][1]) + (v[q][j][2] * v[q][j][2] + v[q][j][3] * v[q][j][3]);
        ss[0] = wave_sum(ss[0], lane); ss[1] = wave_sum(ss[1], lane);
        const float rx[2] = {rsqrtf(ss[0] * (1.0f / 1024.0f) + 1e-6f), rsqrtf(ss[1] * (1.0f / 1024.0f) + 1e-6f)};
#pragma unroll
        for (int j = 0; j < 4; ++j) { const f32x4 pr = *(const f32x4*)(preg + lane * 4 + 256 * j), sh = *(const f32x4*)(msh + lane * 4 + 256 * j), sc = *(const f32x4*)(msc + lane * 4 + 256 * j);
#pragma unroll
            for (int q = 0; q < 2; ++q) {
                const f32x4 hv = v[q][j] * rx[q] * pr * (sc + 1.0f) + sh;
                if (GATES) v[q][j] = hv;
                u32x2 w; w.x = pk2(hv[0], hv[1]); w.y = pk2(hv[2], hv[3]);
                __builtin_nontemporal_store(w, (u32x2*)(hrow + q * 1024 + lane * 4 + 256 * j)); } }
        if (GATES) {
            float mine0 = 0.f, mine1 = 0.f;
#pragma unroll 2
            for (int g = 0; g < 16; ++g) {
                float s0 = 0.f, s1 = 0.f;
#pragma unroll
                for (int j = 0; j < 4; ++j) { const f32x4 w = *(const LAS f32x4*)(wgT + g * 1024 + lane * 4 + 256 * j);
                    s0 += (v[0][j][0] * w[0] + v[0][j][1] * w[1]) + (v[0][j][2] * w[2] + v[0][j][3] * w[3]);
                    s1 += (v[1][j][0] * w[0] + v[1][j][1] * w[1]) + (v[1][j][2] * w[2] + v[1][j][3] * w[3]); }
                s0 = wave_sum(s0, lane); s1 = wave_sum(s1, lane);
                if (lane == g) { mine0 = s0; mine1 = s1; }
            }
            if (lane < 16) { grow[lane] = mine0 + gate_b[lane]; grow[16 + lane] = mine1 + gate_b[lane]; }
        }
    }
}

__device__ __forceinline__ void transpose_item(const float* W, int ldsrc, int K, bf16_t* WT, int nblk, LAS float* scr, int item, int lane) {
    const int kb = item / nblk, nb = item % nblk, k0 = 64 * kb, n0 = 32 * nb;
#pragma unroll 8
    for (int i = 0; i < 32; ++i) { const int kk = 2 * i + (lane >> 5); scr[kk * 33 + (lane & 31)] = W[(size_t)(k0 + kk) * ldsrc + n0 + (lane & 31)]; }
    LDS_WAIT();
    const int c = lane & 7;
#pragma unroll
    for (int j = 0; j < 4; ++j) { const int n = (lane >> 3) + 8 * j; const LAS float* s = scr + (8 * c) * 33 + n;
        u32x4 o; o.x = pk2(s[0 * 33], s[1 * 33]); o.y = pk2(s[2 * 33], s[3 * 33]); o.z = pk2(s[4 * 33], s[5 * 33]); o.w = pk2(s[6 * 33], s[7 * 33]);
        *(u32x4*)(WT + (size_t)(n0 + n) * K + k0 + 8 * c) = o; }
    LDS_WAIT();
}

__device__ __forceinline__ void ada_item(const P& p, LAS unsigned char* lds, int it, const int tid) {
    const int col = tid & 63, kg = __builtin_amdgcn_readfirstlane(tid >> 6);
    const int l = it / 96, n0 = (it % 96) * 64;
    LAS float* S = (LAS float*)lds;
    float acc[36];
#pragma unroll
    for (int r = 0; r < 36; ++r) acc[r] = 0.f;
    const float* W = p.ada_w + (size_t)l * 1024 * 6144;
#pragma unroll 1
    for (int kh = 0; kh < 2; ++kh) {
        __syncthreads();
        for (int r = 0; r < 36; ++r) {
            float sv = 0.f;
            if (r < 32) sv = silu_f(p.c[r * 1024 + kh * 512 + tid]); else if (r == 32) sv = silu_f(p.c_ctx[kh * 512 + tid]);
            S[tid * 36 + r] = sv;
        }
        __syncthreads();
#pragma unroll 2
        for (int kk = 0; kk < 64; ++kk) {
            const int kl = kg * 64 + kk;
            const float w = W[(size_t)(kh * 512 + kl) * 6144 + n0 + col];
#pragma unroll
            for (int r4 = 0; r4 < 9; ++r4) { const f32x4 s = *(const LAS f32x4*)(S + kl * 36 + r4 * 4);
                acc[r4 * 4 + 0] += s[0] * w; acc[r4 * 4 + 1] += s[1] * w; acc[r4 * 4 + 2] += s[2] * w; acc[r4 * 4 + 3] += s[3] * w; }
        }
    }
    __syncthreads();
    LAS float* R = (LAS float*)lds;
#pragma unroll
    for (int r = 0; r < 36; ++r) R[(kg * 36 + r) * 64 + col] = acc[r];
    __syncthreads();
    float* MOD = (float*)(p.ws + OFF_MOD);
    for (int idx = tid; idx < 33 * 64; idx += 512) {
        const int r = idx >> 6, cc = idx & 63; float s = 0.f;
#pragma unroll
        for (int k8 = 0; k8 < 8; ++k8) s += R[(k8 * 36 + r) * 64 + cc];
        MOD[(size_t)(l * 33 + r) * 6144 + n0 + cc] = s + p.ada_b[l * 6144 + n0 + cc];
    }
    __syncthreads();
}

__device__ __forceinline__ void prologue(const P& p, LAS unsigned char* lds, const int tid) {
    const int wave = __builtin_amdgcn_readfirstlane(tid >> 6), lane = tid & 63;
    const int G = gridDim.x;
    for (int it = blockIdx.x; it < 192; it += G) ada_item(p, lds, it, tid);
    __syncthreads();
    LAS float* scr = (LAS float*)(lds + wave * 16384);
    const int gw = blockIdx.x * 8 + wave, NGW = G * 8;
    unsigned char* ws = p.ws;
#define SEG(SRC, LDSRC, KK, NC, DST) { const int nblk = (NC) / 32, nit = ((KK) / 64) * nblk; \
        for (int it = gw; it < nit; it += NGW) transpose_item((SRC), (LDSRC), (KK), (DST), nblk, scr, it, lane); }
    SEG(p.ab_w_in + 0,    3088, 1024, 512, (bf16_t*)(ws + OFF_W0N) + (size_t)0 * 1024)
    SEG(p.ab_w_in + 1040, 3088, 1024, 512, (bf16_t*)(ws + OFF_W0N) + (size_t)512 * 1024)
    SEG(p.ab_w_in + 1552, 3088, 1024, 512, (bf16_t*)(ws + OFF_W0N) + (size_t)1024 * 1024)
    SEG(p.ab_w_in + 2064, 3088, 1024, 512, (bf16_t*)(ws + OFF_W0N) + (size_t)1536 * 1024)
    SEG(p.ab_w_in + 512,  3088, 1024, 512, (bf16_t*)(ws + OFF_W0T) + (size_t)0 * 1024)
    SEG(p.ab_w_in + 2576, 3088, 1024, 512, (bf16_t*)(ws + OFF_W0T) + (size_t)512 * 1024)
    SEG(p.ab_w_out, 1024, 1024, 1024, (bf16_t*)(ws + OFF_WO0))
    SEG(p.ffn_up, 5632, 1024, 5632, (bf16_t*)(ws + OFF_WUP0))
    SEG(p.ffn_up + (size_t)1024 * 5632, 5632, 1024, 5632, (bf16_t*)(ws + OFF_WUP1))
    SEG(p.ffn_down, 1024, 2816, 1024, (bf16_t*)(ws + OFF_WDN0))
    SEG(p.ffn_down + (size_t)2816 * 1024, 1024, 2816, 1024, (bf16_t*)(ws + OFF_WDN1))
    SEG(p.ret_w_in + 0,    6144, 1024, 1024, (bf16_t*)(ws + OFF_W1N) + (size_t)0 * 1024)
    SEG(p.ret_w_in + 3072, 6144, 1024, 1024, (bf16_t*)(ws + OFF_W1N) + (size_t)1024 * 1024)
    SEG(p.ret_w_in + 4096, 6144, 1024, 2048, (bf16_t*)(ws + OFF_W1N) + (size_t)2048 * 1024)
    SEG(p.ret_w_in + 1024, 6144, 1024, 2048, (bf16_t*)(ws + OFF_W1T))
    SEG(p.ret_w_out, 1024, 2048, 1024, (bf16_t*)(ws + OFF_WO1))
#undef SEG
    { bf16_t* SW = (bf16_t*)(ws + OFF_SGUW);
      for (int idx = blockIdx.x * 512 + tid; idx < 4 * 128 * 128; idx += G * 512) SW[idx] = (bf16_t)f2bf(p.ab_sgu_w[idx]); }
}


__device__ __forceinline__ void scan_seq(const P& p, int sq, int lane) {
    const float* GT = (const float*)(p.ws + OFF_GATES);
    float* ROWT = (float*)(p.ws + OFF_ROWT); float* COLT = (float*)(p.ws + OFF_COLT); float* ENM = (float*)(p.ws + OFF_ENM);
    const int bl = sq >> 3, h = (sq >> 1) & 3, dir = sq & 1;
    const int gi = (2 * dir) * 4 + h, gf = (2 * dir + 1) * 4 + h;
    const size_t rb = (size_t)bl * LT;
#define JMAP(pp) (dir == 0 ? (pp) : ((pp) < 256 ? 255 - (pp) : 2559 - (pp)))
    float tot = 0.f;
#pragma unroll 6
    for (int e = 0; e < 36; ++e) { const int pp = lane * 36 + e; const int j = JMAP(pp); tot += logsig(GT[(rb + j) * 16 + gf]); }
    float inc = tot;
#pragma unroll
    for (int o = 1; o < 64; o <<= 1) { const float t = shfl_up_l(inc, o, lane); if (lane >= o) inc += t; }
    const float excl = inc - tot;
    float B = excl, mx = -INFINITY;
#pragma unroll 6
    for (int e = 0; e < 36; ++e) { const int pp = lane * 36 + e; const int j = JMAP(pp); B += logsig(GT[(rb + j) * 16 + gf]); mx = fmaxf(mx, GT[(rb + j) * 16 + gi] - B); }
    float incm = mx;
#pragma unroll
    for (int o = 1; o < 64; o <<= 1) { const float t = shfl_up_l(incm, o, lane); if (lane >= o) incm = fmaxf(incm, t); }
    float cm = shfl_up_l(incm, 1, lane); if (lane == 0) cm = -INFINITY;
    B = excl;
#pragma unroll 6
    for (int e = 0; e < 36; ++e) { const int pp = lane * 36 + e; const int j = JMAP(pp);
        B += logsig(GT[(rb + j) * 16 + gf]); const float a = GT[(rb + j) * 16 + gi] - B; cm = fmaxf(cm, a);
        const size_t oi = (size_t)sq * LT + j;
        ROWT[oi] = -cm * LOG2E; COLT[oi] = a * LOG2E; ENM[oi] = fast_exp2(-(B + cm) * LOG2E); }
#undef JMAP
}
__device__ __forceinline__ void conv_row(const P& p, int r, int lane) {
    const bf16_t* PN = (const bf16_t*)(p.ws + OFF_PN);
    const int j = r % LT; const bool hasp = (j != 0 && j != 256), hasn = (j != 255 && j != 2303);
    const int c0 = lane * 8;
#pragma unroll
    for (int which = 0; which < 2; ++which) {
        const int so = which == 0 ? 512 : 0, wo = which == 0 ? 0 : 512;
        bf16_t* dst = (bf16_t*)(p.ws + (which == 0 ? OFF_QC : OFF_KC));
        const float scale = which == 0 ? 1.0f : 0.08838834764831845f;
        float cur[8], prv[8], nxt[8];
        unpack8(*(const u32x4*)(PN + (size_t)r * 2048 + so + c0), cur);
        if (hasp) unpack8(*(const u32x4*)(PN + (size_t)(r - 1) * 2048 + so + c0), prv); else { for (int i = 0; i < 8; ++i) prv[i] = 0.f; }
        if (hasn) unpack8(*(const u32x4*)(PN + (size_t)(r + 1) * 2048 + so + c0), nxt); else { for (int i = 0; i < 8; ++i) nxt[i] = 0.f; }
        float o[8];
#pragma unroll
        for (int i = 0; i < 8; ++i) {
            const float w0 = p.ab_qk_conv[0 * 1024 + wo + c0 + i], w1 = p.ab_qk_conv[1 * 1024 + wo + c0 + i], w2 = p.ab_qk_conv[2 * 1024 + wo + c0 + i];
            o[i] = silu_f(w0 * prv[i] + w1 * cur[i] + w2 * nxt[i]) * scale;
        }
        u32x4 w; w.x = pk2(o[0], o[1]); w.y = pk2(o[2], o[3]); w.z = pk2(o[4], o[5]); w.w = pk2(o[6], o[7]);
        __builtin_nontemporal_store(w, (u32x4*)(dst + (size_t)r * 512 + c0));
    }
}
__device__ __forceinline__ void conv_rows4(const P& p, int r, int lane) {
    const bf16_t* PN = (const bf16_t*)(p.ws + OFF_PN);
    const int j = r % LT; const bool hasp = (j != 0 && j != 256), hasn = (j + 3 != 255 && j + 3 != 2303);
    const int c0 = lane * 8;
#pragma unroll
    for (int which = 0; which < 2; ++which) {
        const int so = which == 0 ? 512 : 0, wo = which == 0 ? 0 : 512;
        bf16_t* dst = (bf16_t*)(p.ws + (which == 0 ? OFF_QC : OFF_KC));
        const float scale = which == 0 ? 1.0f : 0.08838834764831845f;
        float x[6][8];
#pragma unroll
        for (int k = 0; k < 6; ++k) {
            const bool valid = k == 0 ? hasp : (k == 5 ? hasn : true);
            u32x4 v = (u32x4){0u, 0u, 0u, 0u};
            if (valid) v = *(const u32x4*)(PN + (size_t)(r - 1 + k) * 2048 + so + c0);
            unpack8(v, x[k]);
        }
        float w0[8], w1[8], w2[8];
#pragma unroll
        for (int hq = 0; hq < 2; ++hq) {
            const f32x4 a0 = *(const f32x4*)(p.ab_qk_conv + 0 * 1024 + wo + c0 + 4 * hq), a1 = *(const f32x4*)(p.ab_qk_conv + 1 * 1024 + wo + c0 + 4 * hq), a2 = *(const f32x4*)(p.ab_qk_conv + 2 * 1024 + wo + c0 + 4 * hq);
#pragma unroll
            for (int e = 0; e < 4; ++e) { w0[4 * hq + e] = a0[e]; w1[4 * hq + e] = a1[e]; w2[4 * hq + e] = a2[e]; }
        }
#pragma unroll
        for (int o4 = 0; o4 < 4; ++o4) {
            float o[8];
#pragma unroll
            for (int i = 0; i < 8; ++i) o[i] = silu_f(w0[i] * x[o4][i] + w1[i] * x[o4 + 1][i] + w2[i] * x[o4 + 2][i]) * scale;
            u32x4 w; w.x = pk2(o[0], o[1]); w.y = pk2(o[2], o[3]); w.z = pk2(o[4], o[5]); w.w = pk2(o[6], o[7]);
            __builtin_nontemporal_store(w, (u32x4*)(dst + (size_t)(r + o4) * 512 + c0));
        }
    }
}
__device__ __forceinline__ void valn_block(const P& p, LAS unsigned char* lds, int item, const int tid) {
    const int wave = __builtin_amdgcn_readfirstlane(tid >> 6), lane = tid & 63, rs = lane >> 4, tc = lane & 15;
    char* base = (char*)((bf16_t*)(p.ws + OFF_VT0) + (size_t)(512 + wave * 64) * TG + (size_t)item * 128) + ((unsigned)rs * (unsigned)(TG * 2) + (unsigned)tc * 16u);
    LAS float* R = (LAS float*)lds;
    u32x4 val[16];
    float s[8], q[8];
#pragma unroll
    for (int e = 0; e < 8; ++e) { s[e] = 0.f; q[e] = 0.f; }
#pragma unroll
    for (int it = 0; it < 16; ++it) {
        val[it] = *(const u32x4*)(base + (size_t)it * 4 * TG * 2);
        float f[8]; unpack8(val[it], f);
#pragma unroll
        for (int e = 0; e < 8; ++e) { s[e] += f[e]; q[e] += f[e] * f[e]; }
    }
#pragma unroll
    for (int e = 0; e < 8; ++e) { s[e] += shfl_xor_l(s[e], 16, lane); s[e] += shfl_xor_l(s[e], 32, lane); q[e] += shfl_xor_l(q[e], 16, lane); q[e] += shfl_xor_l(q[e], 32, lane); }
    __syncthreads();
    if (rs == 0) {
        LAS f32x4* dst = (LAS f32x4*)(R + (wave * 16 + tc) * 16);
        dst[0] = (f32x4){s[0], s[1], s[2], s[3]}; dst[1] = (f32x4){s[4], s[5], s[6], s[7]}; dst[2] = (f32x4){q[0], q[1], q[2], q[3]}; dst[3] = (f32x4){q[4], q[5], q[6], q[7]};
    }
    __syncthreads();
#pragma unroll
    for (int e = 0; e < 8; ++e) { s[e] = 0.f; q[e] = 0.f; }
#pragma unroll
    for (int w8 = 0; w8 < 8; ++w8) {
        const LAS f32x4* src = (const LAS f32x4*)(R + (w8 * 16 + tc) * 16);
        const f32x4 a0 = src[0], a1 = src[1], b0 = src[2], b1 = src[3];
        s[0] += a0[0]; s[1] += a0[1]; s[2] += a0[2]; s[3] += a0[3]; s[4] += a1[0]; s[5] += a1[1]; s[6] += a1[2]; s[7] += a1[3];
        q[0] += b0[0]; q[1] += b0[1]; q[2] += b0[2]; q[3] += b0[3]; q[4] += b1[0]; q[5] += b1[1]; q[6] += b1[2]; q[7] += b1[3];
    }
    float mean[8], rstd[8];
#pragma unroll
    for (int e = 0; e < 8; ++e) { mean[e] = s[e] * (1.0f / 512.0f); rstd[e] = rsqrtf(fmaxf(q[e] * (1.0f / 512.0f) - mean[e] * mean[e], 0.f) + 1e-6f); }
#pragma unroll
    for (int it = 0; it < 16; ++it) {
        float f[8]; unpack8(val[it], f);
        u32x4 w; w.x = pk2((f[0] - mean[0]) * rstd[0], (f[1] - mean[1]) * rstd[1]); w.y = pk2((f[2] - mean[2]) * rstd[2], (f[3] - mean[3]) * rstd[3]);
        w.z = pk2((f[4] - mean[4]) * rstd[4], (f[5] - mean[5]) * rstd[5]); w.w = pk2((f[6] - mean[6]) * rstd[6], (f[7] - mean[7]) * rstd[7]);
        *(u32x4*)(base + (size_t)it * 4 * TG * 2) = w;
    }
}

__device__ __forceinline__ void convglu(const P& p, int layer, bool combined, const int tid) {
    const bf16_t* AG = (const bf16_t*)(p.ws + OFF_AG); bf16_t* ACT = (bf16_t*)(p.ws + OFF_ACT);
    const float* WC = p.ffn_conv + (size_t)layer * 9 * DFF;
    const int G8 = gridDim.x >> 3, xcd = blockIdx.x & 7, bix = blockIdx.x >> 3;
    const int rows_per_b = combined ? LT : SEQ, lat0 = combined ? 256 : 0;
    constexpr int BPX = NB / 8;
    const int nlat = BPX * 32 * 8 * 352;
    for (int idx = bix * 512 + tid; idx < nlat; idx += G8 * 512) {
        const int cgl = idx & 31, cb = (idx >> 5) & 7, gr = (idx >> 8) & 31, rest = idx >> 13, cgp = (rest % 11) * 32 + cgl, bl = xcd * BPX + rest / 11;
        const int c = cgp * 8;
        const size_t row0 = (size_t)bl * rows_per_b + lat0 + gr * 64 + cb * 8;
        float acc[8][8];
#pragma unroll
        for (int o = 0; o < 8; ++o)
#pragma unroll
            for (int i = 0; i < 8; ++i) acc[o][i] = 0.f;
#pragma unroll
        for (int dr = 0; dr < 3; ++dr) {
            const int rr = gr + dr - 1;
            if (rr < 0 || rr >= 32) continue;
            u32x4 win[10];
#pragma unroll
            for (int dc = 0; dc < 10; ++dc) {
                const int cc = cb * 8 + dc - 1;
                win[dc] = (u32x4){0u, 0u, 0u, 0u};
                if (cc >= 0 && cc < 64) win[dc] = *(const u32x4*)(AG + (row0 + (long)(dr - 1) * 64 + (dc - 1)) * 5632 + DFF + c);
            }
            float wt[3][8];
#pragma unroll
            for (int t3 = 0; t3 < 3; ++t3) { const f32x4 w0 = *(const f32x4*)(WC + (dr * 3 + t3) * DFF + c), w1 = *(const f32x4*)(WC + (dr * 3 + t3) * DFF + c + 4);
                wt[t3][0] = w0[0]; wt[t3][1] = w0[1]; wt[t3][2] = w0[2]; wt[t3][3] = w0[3]; wt[t3][4] = w1[0]; wt[t3][5] = w1[1]; wt[t3][6] = w1[2]; wt[t3][7] = w1[3]; }
#pragma unroll
            for (int dc = 0; dc < 10; ++dc) {
                float gv[8]; unpack8(win[dc], gv);
#pragma unroll
                for (int o = 0; o < 8; ++o) { const int t3 = dc - o;
                    if (t3 >= 0 && t3 < 3) {
#pragma unroll
                        for (int i = 0; i < 8; ++i) acc[o][i] += gv[i] * wt[t3][i]; } }
            }
        }
#pragma unroll
        for (int o = 0; o < 8; ++o) {
            float av[8]; unpack8(__builtin_nontemporal_load((const u32x4*)(AG + (row0 + o) * 5632 + c)), av);
            u32x4 w; w.x = pk2(gelu_f(acc[o][0]) * av[0], gelu_f(acc[o][1]) * av[1]); w.y = pk2(gelu_f(acc[o][2]) * av[2], gelu_f(acc[o][3]) * av[3]);
            w.z = pk2(gelu_f(acc[o][4]) * av[4], gelu_f(acc[o][5]) * av[5]); w.w = pk2(gelu_f(acc[o][6]) * av[6], gelu_f(acc[o][7]) * av[7]);
            __builtin_nontemporal_store(w, (u32x4*)(ACT + (row0 + o) * DFF + c));
        }
    }
    if (combined) {
        const int nctx = BPX * 256 * 352;
        for (int idx = bix * 512 + tid; idx < nctx; idx += G8 * 512) {
            const int cgp = idx % 352, rest = idx / 352, j = rest & 255, bl = xcd * BPX + (rest >> 8);
            const int c = cgp * 8;
            const size_t row = (size_t)bl * LT + j;
            float acc[8];
#pragma unroll
            for (int i = 0; i < 8; ++i) acc[i] = 0.f;
#pragma unroll
            for (int dc = 0; dc < 3; ++dc) {
                const int jj = j + dc - 1;
                if (jj >= 0 && jj < 256) {
                    float gv[8]; unpack8(*(const u32x4*)(AG + (row + dc - 1) * 5632 + DFF + c), gv);
                    const f32x4 w0 = *(const f32x4*)(WC + (3 + dc) * DFF + c), w1 = *(const f32x4*)(WC + (3 + dc) * DFF + c + 4);
                    acc[0] += gv[0] * w0[0]; acc[1] += gv[1] * w0[1]; acc[2] += gv[2] * w0[2]; acc[3] += gv[3] * w0[3];
                    acc[4] += gv[4] * w1[0]; acc[5] += gv[5] * w1[1]; acc[6] += gv[6] * w1[2]; acc[7] += gv[7] * w1[3];
                }
            }
            float av[8]; unpack8(*(const u32x4*)(AG + row * 5632 + c), av);
            u32x4 w; w.x = pk2(gelu_f(acc[0]) * av[0], gelu_f(acc[1]) * av[1]); w.y = pk2(gelu_f(acc[2]) * av[2], gelu_f(acc[3]) * av[3]);
            w.z = pk2(gelu_f(acc[4]) * av[4], gelu_f(acc[5]) * av[5]); w.w = pk2(gelu_f(acc[6]) * av[6], gelu_f(acc[7]) * av[7]);
            *(u32x4*)(ACT + row * DFF + c) = w;
        }
    }
}

#define XB_TMO      128
#define XB_XCNT(j)  (256  + 64 * (j))
#define XB_XSUB(j)  (1280 + 64 * (j))
#define XB_XGEN(j)  (2304 + 64 * (j))
#define XB_TOP      3328
#define XB_TOPGEN   3392
#define XCD_BAR_WORDS 3456
#define XB_SPIN_CAP (1u << 22)
__device__ __forceinline__ unsigned xb_ld(unsigned* p)              { return __hip_atomic_load(p, __ATOMIC_RELAXED, __HIP_MEMORY_SCOPE_AGENT); }
__device__ __forceinline__ unsigned xb_add(unsigned* p, unsigned v) { return __hip_atomic_fetch_add(p, v, __ATOMIC_RELAXED, __HIP_MEMORY_SCOPE_AGENT); }
__device__ __forceinline__ unsigned xb_xcc_id() { return (unsigned)__builtin_amdgcn_s_getreg((3 << 11) | 20) & 0xFu; }
#define XB_SPIN(cond, bar) do { unsigned _sp = 0; while (cond) { __builtin_amdgcn_s_sleep(1); \
    if ((++_sp & 255u) == 0u) { if (xb_ld(&(bar)[XB_TMO])) break; if (_sp > XB_SPIN_CAP) { atomicAdd(&(bar)[XB_TMO], 1u); break; } } } } while (0)
struct XcdBarrier { unsigned* bar; unsigned x; volatile LAS unsigned* st; };
__device__ __forceinline__ XcdBarrier xcd_barrier_post(unsigned* bar, volatile LAS unsigned* st, bool leader) {
    XcdBarrier b; b.bar = bar; b.x = xb_xcc_id(); b.st = st;
    if (leader) (void)xb_add(&bar[XB_XCNT(b.x)], 1u);
    return b;
}
__device__ __forceinline__ void xcd_barrier_complete(unsigned* bar, unsigned x, unsigned& nloc, unsigned& nx) {
    const unsigned G = gridDim.x * gridDim.y * gridDim.z;
    unsigned sum, cnt, mine, sp = 0u;
    for (;;) {
        sum = 0u; cnt = 0u; mine = 0u;
#pragma unroll
        for (unsigned j = 0; j < 16; ++j) { const unsigned c = xb_ld(&bar[XB_XCNT(j)]); sum += c; cnt += (c > 0u) ? 1u : 0u; mine = (j == x) ? c : mine; }
        if (sum == G) break;
        __builtin_amdgcn_s_sleep(1);
        if ((++sp & 255u) == 0u) { if (xb_ld(&bar[XB_TMO])) break; if (sp > XB_SPIN_CAP) { atomicAdd(&bar[XB_TMO], 1u); break; } }
    }
    nloc = mine > 0u ? mine : 1u; nx = cnt > 0u ? cnt : 1u;
}
__device__ __forceinline__ void xcd_barrier(const XcdBarrier& b, bool leader) {
    asm volatile("s_waitcnt vmcnt(0)" ::: "memory");
    __syncthreads();
    if (leader) {
        unsigned* bar = b.bar;
        __builtin_amdgcn_s_waitcnt(0);
        unsigned nloc = b.st[0], nx = b.st[1];
        if (nloc == 0u) { xcd_barrier_complete(bar, b.x, nloc, nx); b.st[0] = nloc; b.st[1] = nx; }
        const unsigned old = xb_add(&bar[XB_XSUB(b.x)], 1u);
        const unsigned gen = old / nloc;
        if (old + 1u == (gen + 1u) * nloc) {
            __builtin_amdgcn_fence(__ATOMIC_RELEASE, "agent");
            asm volatile("s_waitcnt vmcnt(0)" ::: "memory");
            const unsigned og = xb_add(&bar[XB_TOP], 1u);
            const unsigned tg = og / nx;
            if (og + 1u == (tg + 1u) * nx) xb_add(&bar[XB_TOPGEN], 1u);
            else XB_SPIN(xb_ld(&bar[XB_TOPGEN]) == tg, bar);
            __builtin_amdgcn_fence(__ATOMIC_ACQUIRE, "agent");
            xb_add(&bar[XB_XGEN(b.x)], 1u);
            asm volatile("s_waitcnt vmcnt(0)" ::: "memory");
        } else {
            XB_SPIN(xb_ld(&bar[XB_XGEN(b.x)]) == gen, bar);
            __builtin_amdgcn_fence(__ATOMIC_ACQUIRE, "agent");
            asm volatile("s_waitcnt vmcnt(0)" ::: "memory");
        }
    }
    __syncthreads();
}

struct Args { const float* in[22]; float* out; unsigned char* ws; int ph_lo, ph_hi; };

__global__ void __launch_bounds__(512, 2) mega(Args a) {
    extern __shared__ __attribute__((aligned(16))) unsigned char shm[];
    LAS unsigned char* lds = (LAS unsigned char*)shm;
    cg::grid_group grid = cg::this_grid();
    typedef const __attribute__((address_space(4))) Args* KArgPtr;
#define LOAD_P() KArgPtr ap = (KArgPtr)__builtin_amdgcn_kernarg_segment_ptr(); asm volatile("" : "+s"(ap)); P p; \
    p.x = ap->in[0]; p.c = ap->in[1]; p.ctx = ap->in[2]; p.c_ctx = ap->in[3]; p.ada_w = ap->in[4]; p.ada_b = ap->in[5]; p.pre_g = ap->in[6]; p.post_g = ap->in[7]; \
    p.ffn_up = ap->in[8]; p.ffn_conv = ap->in[9]; p.ffn_down = ap->in[10]; p.ab_w_in = ap->in[11]; p.ab_qk_conv = ap->in[12]; p.ab_gate_b = ap->in[13]; p.ab_sgu_w = ap->in[14]; \
    p.ab_sgu_b = ap->in[15]; p.ab_head_g = ap->in[16]; p.ab_w_out = ap->in[17]; p.ret_w_in = ap->in[18]; p.ret_decay = ap->in[19]; p.ret_head_g = ap->in[20]; p.ret_w_out = ap->in[21]; \
    p.out = ap->out; p.ws = ap->ws;
    const int G = gridDim.x, NGW = G * 8;
    const int lo = a.ph_lo, hi = a.ph_hi;
    int pc = 0;
    const bool fused = (hi - lo) > 1;
    const int wave0 = __builtin_amdgcn_readfirstlane((int)threadIdx.x >> 6);
#define LANE_ID() ([]() __attribute__((always_inline)) { int l_; asm volatile("v_mbcnt_lo_u32_b32 %0, -1, 0\n\tv_mbcnt_hi_u32_b32 %0, -1, %0" : "=v"(l_)); return l_; }())
#define IS_LEADER() (wave0 == 0 && LANE_ID() == 0)
    volatile LAS unsigned* xst = (volatile LAS unsigned*)(lds + LDS_BYTES - 64);
    if (IS_LEADER()) { xst[0] = 0u; xst[1] = 0u; }
    __syncthreads();
    XcdBarrier xb; xb.bar = (unsigned*)(a.ws + OFF_BAR); xb.x = 0; xb.st = xst;
    if (fused) xb = xcd_barrier_post((unsigned*)(a.ws + OFF_BAR), xst, IS_LEADER());
#ifndef ONLY_PHASE
#define ONLY_PHASE -1
#endif
#ifndef DUP_MASK
#define DUP_MASK 0
#endif
#define PH_BEGIN(k) if ((ONLY_PHASE < 0 || ONLY_PHASE == (k)) && pc >= lo && pc < hi) for (int rep_ = 0; rep_ <= ((DUP_MASK >> (k)) & 1); ++rep_) { \
    if (DUP_MASK) __syncthreads(); \
    LOAD_P(); int tid = wave0 * 64 + LANE_ID(); asm volatile("" : "+v"(tid)); unsigned char* ws = p.ws; \
    const int wave = __builtin_amdgcn_readfirstlane(tid >> 6), lane = tid & 63, gw = blockIdx.x * 8 + wave; (void)lane; (void)gw; \
    const float* MOD = (const float*)(ws + OFF_MOD); bf16_t* H = (bf16_t*)(ws + OFF_H); bf16_t* Y = (bf16_t*)(ws + OFF_Y); float* CTXR = (float*)(ws + OFF_CTXR); \
    (void)MOD; (void)H; (void)Y; (void)CTXR;
#define PH_END } ++pc; if (pc > lo && pc < hi) { if (pc == lo + 1) grid.sync(); else xcd_barrier(xb, IS_LEADER()); }


    PH_BEGIN(0) prologue(p, lds, tid); PH_END

#pragma unroll 1
    for (int g = 0; g < NGRP; ++g) {
        const int b0 = g * NB;
        PH_BEGIN(1)
        __syncthreads();
        for (int idx = tid; idx < 16 * 1024; idx += 512) { const int gq = idx >> 10, k = idx & 1023; ((LAS float*)lds)[idx] = p.ab_w_in[(size_t)k * 3088 + 1024 + gq]; }
        __syncthreads();
        for (int r0 = gw * 2; r0 < TG; r0 += NGW * 2)
        { const int rr = 0; const int r = r0 + rr; const int bl = r / LT, j = r % LT, b = b0 + bl;
            const float* xs = j < 256 ? p.ctx + ((size_t)b * 256 + j) * 1024 : p.x + ((size_t)b * SEQ + (j - 256)) * 1024;
            const float* m = MOD + (size_t)(0 * 33 + (j < 256 ? 32 : b)) * 6144;
            row_pass2<true>(xs, nullptr, nullptr, H + (size_t)r * 1024, nullptr, nullptr, p.pre_g + 0 * 1024, m, m + 1024, lane, (const LAS float*)lds, p.ab_gate_b, (float*)(ws + OFF_GATES) + (size_t)r * 16); }
        PH_END
        PH_BEGIN(2)
        { pg8::Sched<pg8::G_L0IN> S; S.ws = ws; S.G = G; S.c = blockIdx.x; pg8::gemm_phase<pg8::G_L0IN>(lds, S, tid); }
        PH_END
        PH_BEGIN(3)
        for (int it = blockIdx.x; it < TG / 128; it += G) valn_block(p, lds, it, tid);
        for (int sq = gw; sq < NB * 8; sq += NGW) scan_seq(p, sq, lane);
        for (int r = gw * 4; r < TG; r += NGW * 4) conv_rows4(p, r, lane);
        PH_END
        PH_BEGIN(4)
        constexpr int N_ML = NB * 4 * 2, N_SGU = NB * 18 * 4;
        if (G >= 2 * N_ML) {
            if ((int)blockIdx.x < N_ML) { const int it = blockIdx.x; mlstm_chunk_item(p, lds, it >> 3, (it >> 1) & 3, it & 1, tid); }
            else for (int i3 = blockIdx.x - N_ML; i3 < N_SGU; i3 += G - N_ML) { const int bl = i3 / 72, rem = i3 % 72; sgu_item(p, bl, rem >> 2, rem & 3, tid); }
        } else
        for (int it = blockIdx.x; it < N_ML + N_SGU; it += G) {
            if (it < N_ML) mlstm_chunk_item(p, lds, it >> 3, (it >> 1) & 3, it & 1, tid);
            else { const int i3 = it - N_ML; const int bl = i3 / 72, rem = i3 % 72; sgu_item(p, bl, rem >> 2, rem & 3, tid); }
        }
        PH_END
        PH_BEGIN(20)
        for (int r = gw * 2; r < TG; r += NGW * 2) { mlstm_post_row(p, r, lane); mlstm_post_row(p, r + 1, lane); }
        PH_END
        PH_BEGIN(5)
        { pg8::Sched<pg8::G_OUT0> S; S.ws = ws; S.G = G; S.c = blockIdx.x; pg8::gemm_phase<pg8::G_OUT0>(lds, S, tid); }
        PH_END
        PH_BEGIN(6)
        for (int r0 = gw * 2; r0 < TG; r0 += NGW * 2)
        { const int rr = 0; const int r = r0 + rr; const int bl = r / LT, j = r % LT, b = b0 + bl;
            const float* xs = j < 256 ? p.ctx + ((size_t)b * 256 + j) * 1024 : p.x + ((size_t)b * SEQ + (j - 256)) * 1024;
            float* xd = j < 256 ? CTXR + ((size_t)bl * 256 + j) * 1024 : p.out + ((size_t)b * SEQ + (j - 256)) * 1024;
            const float* m = MOD + (size_t)(0 * 33 + (j < 256 ? 32 : b)) * 6144;
            row_pass2<false>(xs, Y + (size_t)r * 1024, xd, H + (size_t)r * 1024, p.post_g + 0 * 1024, m + 2 * 1024, p.pre_g + 1 * 1024, m + 3 * 1024, m + 4 * 1024, lane); }
        PH_END
        PH_BEGIN(7)
        { pg8::Sched<pg8::G_UP0> S; S.ws = ws; S.G = G; S.c = blockIdx.x; pg8::gemm_phase<pg8::G_UP0>(lds, S, tid); }
        PH_END
        PH_BEGIN(8) convglu(p, 0, true, tid); PH_END
        PH_BEGIN(9)
        { pg8::Sched<pg8::G_DN0> S; S.ws = ws; S.G = G; S.c = blockIdx.x; pg8::gemm_phase<pg8::G_DN0>(lds, S, tid); }
        PH_END
        PH_BEGIN(10)
        constexpr int NCB = (TG - TL) / 256 * 4;
        if (G >= 2 * NCB && (int)blockIdx.x < NCB) {
            pg8::Sched<pg8::G_DN0C> S; S.ws = ws; S.G = NCB; S.c = blockIdx.x; pg8::gemm_phase<pg8::G_DN0C>(lds, S, tid);
        } else {
            const bool split = G >= 2 * NCB;
            if (!split) { pg8::Sched<pg8::G_DN0C> S; S.ws = ws; S.G = G; S.c = blockIdx.x; pg8::gemm_phase<pg8::G_DN0C>(lds, S, tid); }
            const int gw2 = split ? ((int)blockIdx.x - NCB) * 8 + wave : gw, ngw2 = split ? (G - NCB) * 8 : NGW;
            for (int r0 = gw2 * 2; r0 < TL; r0 += ngw2 * 2)
            { const int rr = 0; const int rl = r0 + rr; const int bl = rl / SEQ, t = rl % SEQ, b = b0 + bl; const size_t r = (size_t)bl * LT + 256 + t;
                float* xd = p.out + ((size_t)b * SEQ + t) * 1024;
                const float* m0 = MOD + (size_t)(0 * 33 + b) * 6144;
                const float* m1 = MOD + (size_t)(1 * 33 + b) * 6144;
                row_pass2<false>(xd, Y + r * 1024, xd, H + r * 1024, p.post_g + 1 * 1024, m0 + 5 * 1024, p.pre_g + 2 * 1024, m1, m1 + 1024, lane); }
        }
        PH_END
        PH_BEGIN(21)
        for (int r0 = gw * 2; r0 < NB * 256; r0 += NGW * 2)
        { const int rr = 0; const int rc = r0 + rr; const int bl = rc >> 8, j = rc & 255; const size_t r = (size_t)bl * LT + j;
            float* xd = CTXR + ((size_t)bl * 256 + j) * 1024;
            const float* m0 = MOD + (size_t)(0 * 33 + 32) * 6144;
            const float* m1 = MOD + (size_t)(1 * 33 + 32) * 6144;
            row_pass2<false>(xd, Y + r * 1024, xd, H + r * 1024, p.post_g + 1 * 1024, m0 + 5 * 1024, p.pre_g + 2 * 1024, m1, m1 + 1024, lane); }
        PH_END
        PH_BEGIN(11)
        { pg8::Sched<pg8::G_L1IN> S; S.ws = ws; S.G = G; S.c = blockIdx.x; pg8::gemm_phase<pg8::G_L1IN>(lds, S, tid); }
        { pg8::Sched<pg8::G_L1B> S; S.ws = ws; S.G = G; S.c = blockIdx.x; pg8::gemm_phase<pg8::G_L1B>(lds, S, tid); }
        PH_END
        PH_BEGIN(12)
        for (int it0 = blockIdx.x; it0 < NB * 4 * 4; it0 += G) {
            const int it = (G == 256) ? (((it0 & 7) * 8 + ((it0 >> 3) >> 2)) * 4 + ((it0 >> 3) & 3)) : it0;
            const int bl = it / 16, rem = it % 16; ret_chunk_item(p, lds, bl, rem >> 2, rem & 3, tid); }
        PH_END
        PH_BEGIN(19)
        for (int r = gw * 2; r < TL; r += NGW * 2) ret_post_row(p, r, lane);
        PH_END
        PH_BEGIN(13)
        { pg8::Sched<pg8::G_OUT1> S; S.ws = ws; S.G = G; S.c = blockIdx.x; pg8::gemm_phase<pg8::G_OUT1>(lds, S, tid); }
        PH_END
        PH_BEGIN(14)
        for (int r0 = gw * 2; r0 < TL; r0 += NGW * 2)
        { const int rr = 0; const int r = r0 + rr; const int bl = r / SEQ, t = r % SEQ, b = b0 + bl;
            float* xd = p.out + ((size_t)b * SEQ + t) * 1024;
            const float* m1 = MOD + (size_t)(1 * 33 + b) * 6144;
            row_pass2<false>(xd, Y + (size_t)r * 1024, xd, H + (size_t)r * 1024, p.post_g + 2 * 1024, m1 + 2 * 1024, p.pre_g + 3 * 1024, m1 + 3 * 1024, m1 + 4 * 1024, lane); }
        PH_END
        PH_BEGIN(15)
        { pg8::Sched<pg8::G_UP1> S; S.ws = ws; S.G = G; S.c = blockIdx.x; pg8::gemm_phase<pg8::G_UP1>(lds, S, tid); }
        PH_END
        PH_BEGIN(16) convglu(p, 1, false, tid); PH_END
        PH_BEGIN(17)
        { pg8::Sched<pg8::G_DN1> S; S.ws = ws; S.G = G; S.c = blockIdx.x; pg8::gemm_phase<pg8::G_DN1>(lds, S, tid); }
        PH_END
        PH_BEGIN(18)
        for (int r0 = gw * 2; r0 < TL; r0 += NGW * 2)
        { const int rr = 0; const int r = r0 + rr; const int bl = r / SEQ, t = r % SEQ, b = b0 + bl;
            float* xd = p.out + ((size_t)b * SEQ + t) * 1024;
            const float* m1 = MOD + (size_t)(1 * 33 + b) * 6144;
            row_pass2<false>(xd, Y + (size_t)r * 1024, xd, nullptr, p.post_g + 3 * 1024, m1 + 5 * 1024, nullptr, nullptr, nullptr, lane); }
        PH_END
    }
#undef PH_BEGIN
#undef PH_END
}

extern "C" void kernel_launch(void* const* d_in, const int* in_sizes, int n_in, void* d_out, int out_size, void* d_ws, size_t ws_size, hipStream_t stream) {
    static int grid = 0;
    if (grid == 0) {
        if (n_in != 22 || ws_size < WS_END) { fprintf(stderr, "kernel_launch: need 22 inputs and %zu bytes of workspace; got %d, %zu\n", (size_t)WS_END, n_in, ws_size); grid = -1; return; }
        int dev = 0, cus = 0, per_cu = 0;
        hipGetDevice(&dev);
        hipDeviceGetAttribute(&cus, hipDeviceAttributeMultiprocessorCount, dev);
        if (hipFuncSetAttribute((const void*)mega, hipFuncAttributeMaxDynamicSharedMemorySize, LDS_BYTES) != hipSuccess) { fprintf(stderr, "kernel_launch: hipFuncSetAttribute failed\n"); grid = -1; return; }
        if (hipOccupancyMaxActiveBlocksPerMultiprocessor(&per_cu, (const void*)mega, 512, LDS_BYTES) != hipSuccess || per_cu < 1) { fprintf(stderr, "kernel_launch: occupancy query says %d\n", per_cu); per_cu = 1; }
        (void)hipGetLastError();
        grid = cus * per_cu;
        if (grid <= 0) grid = 256;
    }
    if (grid < 0) return;
    Args a{};
    for (int i = 0; i < 22; ++i) a.in[i] = (const float*)d_in[i];
    a.out = (float*)d_out; a.ws = (unsigned char*)d_ws;
#if MK_MULTI
    for (int ph = 0; ph < NPHASE; ++ph) {
        a.ph_lo = ph; a.ph_hi = ph + 1;
        hipLaunchKernelGGL(mega, dim3(grid), dim3(512), LDS_BYTES, stream, a);
    }
#else
    a.ph_lo = 0; a.ph_hi = NPHASE;
    if (hipMemsetAsync((char*)d_ws + OFF_BAR, 0, (size_t)XCD_BAR_WORDS_C * 4, stream) != hipSuccess) { fprintf(stderr, "kernel_launch: memset failed\n"); return; }
    void* args[] = {&a};
    hipError_t e = hipLaunchCooperativeKernel((const void*)mega, dim3(grid), dim3(512), args, LDS_BYTES, stream);
    if (e != hipSuccess) fprintf(stderr, "cooperative launch failed: %s (grid %d)\n", hipGetErrorString(e), grid);
#endif
}
```

```cpp
#include <hip/hip_runtime.h>
#include <hip/hip_cooperative_groups.h>
#include <cstdio>
#include <cstdint>
namespace cg = cooperative_groups;

#ifndef MK_MULTI
#define MK_MULTI 0
#endif

#define LAS __attribute__((address_space(3)))
typedef unsigned short bf16_t;
typedef short bf16x8 __attribute__((ext_vector_type(8)));
typedef float f32x4 __attribute__((ext_vector_type(4)));
typedef unsigned u32x4 __attribute__((ext_vector_type(4)));
typedef unsigned u32x2 __attribute__((ext_vector_type(2)));

constexpr int D = 1024, NBATCH = 32, SEQ = 2048, CTXL = 256, LT = 2304;
constexpr int NB = 16, NGRP = NBATCH / NB;
constexpr int TG = NB * LT;
constexpr int TL = NB * SEQ;
constexpr int DFF = 2816;
constexpr int LDS_BYTES = 147456;
constexpr int NPHASE = 1 + NGRP * 21;
constexpr float LOG2E = 1.4426950408889634f;
constexpr int XCD_BAR_WORDS_C = 3456;

constexpr size_t al256(size_t x) { return (x + 255) & ~(size_t)255; }
constexpr size_t OFF_MOD  = 0;
constexpr size_t OFF_W0N  = al256(OFF_MOD + (size_t)2 * 33 * 6144 * 4);
constexpr size_t OFF_W0T  = OFF_W0N + (size_t)2048 * 1024 * 2;
constexpr size_t OFF_WO0  = OFF_W0T + (size_t)1024 * 1024 * 2;
constexpr size_t OFF_WUP0 = OFF_WO0 + (size_t)1024 * 1024 * 2;
constexpr size_t OFF_WUP1 = OFF_WUP0 + (size_t)5632 * 1024 * 2;
constexpr size_t OFF_WDN0 = OFF_WUP1 + (size_t)5632 * 1024 * 2;
constexpr size_t OFF_WDN1 = OFF_WDN0 + (size_t)1024 * 2816 * 2;
constexpr size_t OFF_W1N  = OFF_WDN1 + (size_t)1024 * 2816 * 2;
constexpr size_t OFF_W1T  = OFF_W1N + (size_t)4096 * 1024 * 2;
constexpr size_t OFF_WO1  = OFF_W1T + (size_t)2048 * 1024 * 2;
constexpr size_t OFF_SGUW = OFF_WO1 + (size_t)1024 * 2048 * 2;
constexpr size_t OFF_ROWT = OFF_SGUW + (size_t)4 * 128 * 128 * 2;
constexpr size_t OFF_COLT = OFF_ROWT + (size_t)NB * 8 * LT * 4;
constexpr size_t OFF_ENM  = OFF_COLT + (size_t)NB * 8 * LT * 4;
constexpr size_t OFF_GATES= OFF_ENM + (size_t)NB * 8 * LT * 4;
constexpr size_t OFF_CTXR = OFF_GATES + (size_t)TG * 16 * 4;
constexpr size_t OFF_H    = OFF_CTXR + (size_t)NB * 256 * 1024 * 4;
constexpr size_t OFF_Y    = OFF_H + (size_t)TG * 1024 * 2;
constexpr size_t OFF_BIG  = OFF_Y + (size_t)TG * 1024 * 2;
constexpr size_t OFF_PN   = OFF_BIG;
constexpr size_t OFF_VT0  = OFF_PN + (size_t)TG * 2048 * 2;
constexpr size_t OFF_QC   = OFF_VT0 + (size_t)1024 * TG * 2;
constexpr size_t OFF_KC   = OFF_QC + (size_t)TG * 512 * 2;
constexpr size_t OFF_RF   = OFF_KC + (size_t)TG * 512 * 2;
constexpr size_t OFF_RB   = OFF_RF + (size_t)TG * 512 * 2;
constexpr size_t OFF_AG   = OFF_BIG;
constexpr size_t OFF_ACT  = OFF_AG + (size_t)TG * 5632 * 2;
constexpr size_t OFF_K1   = OFF_BIG;
constexpr size_t OFF_Q1   = OFF_K1 + (size_t)TG * 1024 * 2;
constexpr size_t OFF_G1   = OFF_Q1 + (size_t)TG * 1024 * 2;
constexpr size_t OFF_VT1  = OFF_G1 + (size_t)TG * 2048 * 2;
constexpr size_t OFF_K1T  = OFF_VT1 + (size_t)2048 * TG * 2;
constexpr size_t OFF_MRG  = OFF_K1T + (size_t)1024 * TG * 2;
constexpr size_t END_FFN  = OFF_ACT + (size_t)TG * 2816 * 2;
constexpr size_t OFF_MRG2 = OFF_MRG + (size_t)TL * 2048 * 2;
constexpr size_t END_MIX1 = OFF_MRG2 + (size_t)TL * 2048 * 2;
constexpr size_t OFF_BAR  = al256(END_FFN > END_MIX1 ? END_FFN : END_MIX1);
constexpr size_t WS_END   = OFF_BAR + (size_t)XCD_BAR_WORDS_C * 4;
static_assert(WS_END <= (size_t)1020 * 1024 * 1024, "workspace budget");
static_assert(OFF_RB + (size_t)TG * 512 * 2 <= END_FFN, "mixer0 region");

__device__ __forceinline__ unsigned f2bf(float f) { unsigned u = __float_as_uint(f); return (u + 0x7fffu + ((u >> 16) & 1u)) >> 16; }
__device__ __forceinline__ unsigned pk2(float lo, float hi) { return f2bf(lo) | (f2bf(hi) << 16); }
__device__ __forceinline__ float bf2f(bf16_t b) { return __uint_as_float(((unsigned)b) << 16); }
__device__ __forceinline__ float bflo(unsigned w) { return __uint_as_float(w << 16); }
__device__ __forceinline__ float bfhi(unsigned w) { return __uint_as_float(w & 0xffff0000u); }
__device__ __forceinline__ unsigned cvt_pk_bf16(float lo, float hi) { unsigned r; asm volatile("v_cvt_pk_bf16_f32 %0, %1, %2" : "=v"(r) : "v"(lo), "v"(hi)); return r; }
__device__ __forceinline__ float fast_exp2(float x) { return __builtin_amdgcn_exp2f(x); }
__device__ __forceinline__ float fast_rcp(float x) { return __builtin_amdgcn_rcpf(x); }
__device__ __forceinline__ float logsig(float x) { return fminf(x, 0.f) - 0.6931471805599453f * __builtin_amdgcn_logf(1.0f + fast_exp2(-fabsf(x) * LOG2E)); }
__device__ __forceinline__ float sigmoid_f(float x) { return fast_rcp(1.0f + fast_exp2(-x * LOG2E)); }
__device__ __forceinline__ float silu_f(float x) { return x * sigmoid_f(x); }
__device__ __forceinline__ float gelu_f(float x) {
    const float u = 0.7978845608028654f * (x + 0.044715f * x * x * x);
    return x * fast_rcp(1.0f + fast_exp2(-2.0f * LOG2E * u));
}
__device__ __forceinline__ float shfl_idx(float v, int src) { return __int_as_float(__builtin_amdgcn_ds_bpermute(src << 2, __float_as_int(v))); }
__device__ __forceinline__ float shfl_xor_l(float v, int m, int lane) { return shfl_idx(v, lane ^ m); }
__device__ __forceinline__ float shfl_up_l(float v, int o, int lane) { return shfl_idx(v, (lane - o) & 63); }
__device__ __forceinline__ float wave_sum(float v, int lane) {
#pragma unroll
    for (int o = 1; o < 64; o <<= 1) v += shfl_xor_l(v, o, lane);
    return v;
}
__device__ __forceinline__ void unpack8(const u32x4 w, float (&f)[8]) {
    f[0] = bflo(w.x); f[1] = bfhi(w.x); f[2] = bflo(w.y); f[3] = bfhi(w.y); f[4] = bflo(w.z); f[5] = bfhi(w.z); f[6] = bflo(w.w); f[7] = bfhi(w.w);
}
#define LDS_WAIT() asm volatile("s_waitcnt lgkmcnt(0)" ::: "memory")

namespace pg8 {
constexpr int BM = 256, BK = 64, HALF = 128, HTB = HALF * BK * 2, STAGE_BYTES = 8 * HTB, NXCD = 8, WGM = 8;
__host__ __device__ __forceinline__ int lds_byte(int r, int c) { const int st = (r >> 4) * 2 + (c >> 5), rr = r & 15, cc = c & 31, ob = rr * 64 + cc * 2; return st * 1024 + (ob ^ (((ob >> 9) & 1) << 5)); }
__host__ __device__ __forceinline__ void stage_rc(int b, int& R, int& C) { const int st = b / 1024, sb = b % 1024, swz = sb ^ (((sb >> 9) & 1) << 5); R = (st >> 1) * 16 + swz / 64; C = (st & 1) * 32 + (swz % 64) / 2; }
__host__ __device__ __forceinline__ int perm32(int rho) { const int n = rho >> 4, i = rho & 15; return 8 * (i >> 2) + 4 * n + (i & 3); }

enum { ACT_NONE = 0, ACT_GELU = 1, ACT_SIGMOID = 2, ACT_SILU = 3, ACT_GATES = 9 };
struct Unit { const char* a; const char* b; bf16_t* o; int ldc; int act; float scale; };

enum { G_L0IN = 0, G_OUT0, G_UP0, G_DN0, G_L1IN, G_OUT1, G_UP1, G_DN1, G_L1B, G_DN0C };
template <int PH> struct Sched {
    unsigned char* ws; int G, c;
    static constexpr int KDIM = (PH == G_DN0 || PH == G_DN1 || PH == G_DN0C) ? DFF : (PH == G_OUT1 ? 2048 : 1024);
    static constexpr size_t tstep = (size_t)256 * KDIM * 2;
    static constexpr int MT = TG / 256, ML = TL / 256;
    static constexpr int N0 = PH == G_L0IN ? MT * 8 : PH == G_OUT0 ? MT * 4 : PH == G_UP0 ? MT * 22 : PH == G_DN0 ? ML * 4 : PH == G_DN0C ? (MT - ML) * 4 : PH == G_L1IN ? MT * 4 : PH == G_OUT1 ? ML * 4 : PH == G_UP1 ? ML * 22 : PH == G_L1B ? ML * 12 : ML * 4;
    static constexpr int N1 = PH == G_L0IN ? 4 * MT : PH == G_L1IN ? 8 * MT : 0;
    static constexpr int N2 = 0;
    static constexpr int N3 = 0;
    static __device__ __forceinline__ void tile(int wgid, int nM, int nN, int& pm, int& pn) {
        const int nwg = nM * nN;
        { const int q = nwg / NXCD, r = nwg % NXCD, xcd = wgid % NXCD, off = wgid / NXCD; wgid = (xcd < r ? xcd * (q + 1) : r * (q + 1) + (xcd - r) * q) + off; }
        const int nig = WGM * nN, gid = wgid / nig, fm = gid * WGM, gsz = (nM - fm) < WGM ? (nM - fm) : WGM;
        pm = fm + ((wgid % nig) % gsz); pn = (wgid % nig) / gsz;
    }
    __device__ __forceinline__ void plain(int L, size_t offA, size_t offB, size_t offO, int nM, int nN, Unit& u) const {
        int pm, pn; tile(L, nM, nN, pm, pn);
        u.a = (const char*)ws + offA + (size_t)pm * tstep; u.b = (const char*)ws + offB + (size_t)pn * tstep;
        u.ldc = nN * 256; u.o = (bf16_t*)(ws + offO) + (size_t)pm * 256 * (nN * 256) + pn * 256;
    }
    __device__ __forceinline__ bool next(int i, Unit& u) const {
        const long LL = (long)i * G + c;
        if (LL >= (long)N0 + N1 + N2 + N3) return false;
        const int L = (int)LL;
        u.scale = 1.0f; u.act = ACT_NONE;
        if constexpr (PH == G_L0IN) {
            if (L < N0) { int pm, pn; tile(L, MT, 8, pm, pn);
                u.a = (const char*)ws + OFF_H + (size_t)pm * tstep; u.b = (const char*)ws + OFF_W0N + (size_t)pn * tstep;
                u.o = (bf16_t*)(ws + OFF_PN) + (size_t)pm * 256 * 2048 + pn * 256; u.ldc = 2048; u.act = pn < 4 ? ACT_NONE : (pn < 6 ? ACT_SIGMOID : ACT_GELU);
            } else { int pm, pn; tile(L - N0, 4, MT, pm, pn);
                u.a = (const char*)ws + OFF_W0T + (size_t)pm * tstep; u.b = (const char*)ws + OFF_H + (size_t)pn * tstep;
                u.o = (bf16_t*)(ws + OFF_VT0) + (size_t)pm * 256 * TG + pn * 256; u.ldc = TG; u.act = pm >= 2 ? ACT_GELU : ACT_NONE; }
        } else if constexpr (PH == G_L1IN) {
            if (L < N0) { int pm, pn; tile(L, MT, 4, pm, pn);
                u.a = (const char*)ws + OFF_H + (size_t)pm * tstep; u.b = (const char*)ws + OFF_W1N + (size_t)pn * tstep;
                u.ldc = 1024; u.o = (bf16_t*)(ws + OFF_K1) + (size_t)pm * 256 * 1024 + pn * 256; u.scale = 0.0625f;
            } else if (L < N0 + N1) { int pm, pn; tile(L - N0, 8, MT, pm, pn);
                u.a = (const char*)ws + OFF_W1T + (size_t)pm * tstep; u.b = (const char*)ws + OFF_H + (size_t)pn * tstep;
                u.o = (bf16_t*)(ws + OFF_VT1) + (size_t)pm * 256 * TG + pn * 256; u.ldc = TG;
            } else { int pm, pn; tile(L - N0 - N1, 4, MT, pm, pn);
                u.a = (const char*)ws + OFF_W1N + (size_t)pm * tstep; u.b = (const char*)ws + OFF_H + (size_t)pn * tstep;
                u.o = (bf16_t*)(ws + OFF_K1T) + (size_t)pm * 256 * TG + pn * 256; u.ldc = TG; u.scale = 0.0625f; }
        } else if constexpr (PH == G_L1B) {
            int pm, pn; tile(L, ML, 12, pm, pn);
            const int cm = (pm >> 3) * 9 + 1 + (pm & 7);
            u.a = (const char*)ws + OFF_H + (size_t)cm * tstep; u.b = (const char*)ws + OFF_W1N + (size_t)(4 + pn) * tstep;
            if (pn < 4) { u.ldc = 1024; u.o = (bf16_t*)(ws + OFF_Q1) + (size_t)cm * 256 * 1024 + pn * 256; }
            else { u.ldc = 2048; u.o = (bf16_t*)(ws + OFF_G1) + (size_t)cm * 256 * 2048 + (pn - 4) * 256; u.act = ACT_SILU; }
        }
        else if constexpr (PH == G_OUT0) plain(L, OFF_H, OFF_WO0, OFF_Y, MT, 4, u);
        else if constexpr (PH == G_UP0) plain(L, OFF_H, OFF_WUP0, OFF_AG, MT, 22, u);
        else if constexpr (PH == G_DN0) {
            int pm, pn; tile(L, ML, 4, pm, pn); const int cm = (pm >> 3) * 9 + 1 + (pm & 7);
            u.a = (const char*)ws + OFF_ACT + (size_t)cm * tstep; u.b = (const char*)ws + OFF_WDN0 + (size_t)pn * tstep;
            u.ldc = 1024; u.o = (bf16_t*)(ws + OFF_Y) + (size_t)cm * 256 * 1024 + pn * 256;
        } else if constexpr (PH == G_DN0C) {
            int pm, pn; tile(L, MT - ML, 4, pm, pn); const int cm = pm * 9;
            u.a = (const char*)ws + OFF_ACT + (size_t)cm * tstep; u.b = (const char*)ws + OFF_WDN0 + (size_t)pn * tstep;
            u.ldc = 1024; u.o = (bf16_t*)(ws + OFF_Y) + (size_t)cm * 256 * 1024 + pn * 256;
        }
        else if constexpr (PH == G_OUT1) plain(L, OFF_MRG, OFF_WO1, OFF_Y, ML, 4, u);
        else if constexpr (PH == G_UP1) plain(L, OFF_H, OFF_WUP1, OFF_AG, ML, 22, u);
        else plain(L, OFF_ACT, OFF_WDN1, OFF_Y, ML, 4, u);
        return true;
    }
};

__device__ __forceinline__ f32x4 act4(f32x4 v, int act, float scale) {
    if (act == ACT_GELU) { v[0] = gelu_f(v[0]); v[1] = gelu_f(v[1]); v[2] = gelu_f(v[2]); v[3] = gelu_f(v[3]); }
    else if (act == ACT_SIGMOID) { v[0] = sigmoid_f(v[0]); v[1] = sigmoid_f(v[1]); v[2] = sigmoid_f(v[2]); v[3] = sigmoid_f(v[3]); }
    else if (act == ACT_SILU) { v[0] = silu_f(v[0]); v[1] = silu_f(v[1]); v[2] = silu_f(v[2]); v[3] = silu_f(v[3]); }
    else v = v * scale;
    return v;
}
__device__ __forceinline__ void epi_store(const f32x4 (&acc)[2][2][4][2], const Unit& u, int wr, int wc, int fr, int fq) {
    const int row0 = wr * 64 + fr, col0 = wc * 32 + 8 * fq;
#pragma unroll
    for (int ai = 0; ai < 2; ++ai)
#pragma unroll
        for (int m = 0; m < 4; ++m) {
            bf16_t* rowp = u.o + (size_t)(row0 + ai * HALF + m * 16) * u.ldc + col0;
#pragma unroll
            for (int bj = 0; bj < 2; ++bj) {
                const f32x4 v0 = act4(acc[ai][bj][m][0], u.act, u.scale), v1 = act4(acc[ai][bj][m][1], u.act, u.scale);
                u32x4 w; w.x = cvt_pk_bf16(v0[0], v0[1]); w.y = cvt_pk_bf16(v0[2], v0[3]); w.z = cvt_pk_bf16(v1[0], v1[1]); w.w = cvt_pk_bf16(v1[2], v1[3]);
                *(u32x4*)(rowp + bj * HALF) = w;
            }
        }
}

template <int PH>
__device__ __forceinline__ void gemm_phase(LAS unsigned char* lds, const Sched<PH>& S, const int tid) {
    int K = Sched<PH>::KDIM; asm volatile("" : "+s"(K));
    const int wid = __builtin_amdgcn_readfirstlane(tid >> 6), lane = tid & 63, wr = wid >> 2, wc = wid & 3, fr = lane & 15, fq = lane >> 4;
    const int nt = K / BK;
    unsigned voffA[2], voffB[2];
#pragma unroll
    for (int i = 0; i < 2; ++i) { int R, C; stage_rc(tid * 16 + i * 8192, R, C); const int Rb = (R & ~31) + perm32(R & 31);
        voffA[i] = (unsigned)(R * K + C) * 2u; voffB[i] = (unsigned)(Rb * K + C) * 2u; }
    const size_t kstep = (size_t)(BK * 2);
    const size_t hstep = (size_t)HALF * K * 2;
    const unsigned ldsw = (unsigned)wid * 1024u;
    const unsigned ldsbase = (unsigned)(size_t)lds;
    const int aoff = lds_byte(wr * 64 + fr, fq * 8), boff = lds_byte(wc * 32 + fr, fq * 8);
#define PG8_SA(b, h) (((b) * 2 + (h)) * HTB)
#define PG8_SB(b, h) ((4 + (b) * 2 + (h)) * HTB)
#define PG8_STAGE(bufoff, gbase, voff) do { _Pragma("unroll") for (int _i = 0; _i < 2; ++_i) { \
        const unsigned _m0 = ldsbase + (unsigned)(bufoff) + ldsw + _i * 8192; const char* _gb = (const char*)(gbase); \
        unsigned _keep; asm volatile("s_mov_b32 %0, m0\n\ts_mov_b32 m0, %1\n\ts_nop 0\n\tglobal_load_lds_dwordx4 %2, %3\n\ts_mov_b32 m0, %0" : "=&s"(_keep) : "s"(_m0), "v"((voff)[_i]), "s"(_gb) : "memory"); } } while (0)
#define PG8_LDA(dst, b, h) do { _Pragma("unroll") for (int m = 0; m < 4; ++m) _Pragma("unroll") for (int k = 0; k < 2; ++k) dst[m][k] = *(const LAS bf16x8*)(lds + PG8_SA(b, h) + aoff + m * 2048 + k * 1024); } while (0)
#define PG8_LDB(dst, b, h) do { _Pragma("unroll") for (int n = 0; n < 2; ++n) _Pragma("unroll") for (int k = 0; k < 2; ++k) dst[n][k] = *(const LAS bf16x8*)(lds + PG8_SB(b, h) + boff + n * 2048 + k * 1024); } while (0)
#define PG8_MMA(ai, bj, At, Bt) do { __builtin_amdgcn_s_setprio(1); _Pragma("unroll") for (int m = 0; m < 4; ++m) _Pragma("unroll") for (int n = 0; n < 2; ++n) _Pragma("unroll") for (int k = 0; k < 2; ++k) \
        acc[ai][bj][m][n] = __builtin_amdgcn_mfma_f32_16x16x32_bf16(Bt[n][k], At[m][k], acc[ai][bj][m][n], 0, 0, 0); __builtin_amdgcn_s_setprio(0); } while (0)
#define PG8_WAIT_V(n) asm volatile("s_waitcnt vmcnt(" #n ")" ::: "memory")
#define PG8_WAIT_L(n) asm volatile("s_waitcnt lgkmcnt(" #n ")" ::: "memory")
#define PG8_BAR __builtin_amdgcn_s_barrier()
#define PG8_SCHED __builtin_amdgcn_sched_barrier(0)
    Unit cur, nxt; int ui = 0;
    if (!S.next(0, cur)) return;
    f32x4 acc[2][2][4][2];
#pragma unroll
    for (int a = 0; a < 2; ++a)
#pragma unroll
        for (int b = 0; b < 2; ++b)
#pragma unroll
            for (int m = 0; m < 4; ++m)
#pragma unroll
                for (int n = 0; n < 2; ++n) acc[a][b][m][n] = (f32x4){0.f, 0.f, 0.f, 0.f};
    bf16x8 At[4][2], B0[2][2], B1[2][2];
    const char* cA = cur.a; const char* cB = cur.b;
    PG8_STAGE(PG8_SB(0, 0), cB, voffB); PG8_STAGE(PG8_SB(0, 1), cB + hstep, voffB); PG8_STAGE(PG8_SA(0, 0), cA, voffA); PG8_STAGE(PG8_SA(0, 1), cA + hstep, voffA);
    if (wr == 1) PG8_BAR;
    PG8_WAIT_V(2); PG8_BAR;
    PG8_STAGE(PG8_SB(1, 0), cB + kstep, voffB); PG8_STAGE(PG8_SA(1, 0), cA + kstep, voffA); PG8_STAGE(PG8_SB(1, 1), cB + hstep + kstep, voffB);
    PG8_WAIT_V(6); PG8_BAR;
    for (;;) {
        const bool has_next = S.next(ui + 1, nxt);
        const char* nA = has_next ? nxt.a : cA; const char* nB = has_next ? nxt.b : cB;
        for (int t = 0; t < nt; t += 2) {
            const bool last = (t == nt - 2);
            const char* a1 = cA + (size_t)(t + 1) * kstep;
            const char* a2 = last ? nA : cA + (size_t)(t + 2) * kstep; const char* b2 = last ? nB : cB + (size_t)(t + 2) * kstep;
            const char* a3 = a2 + kstep; const char* b3 = b2 + kstep;
            PG8_LDB(B0, 0, 0); PG8_LDB(B1, 0, 1); PG8_SCHED; PG8_LDA(At, 0, 0); PG8_STAGE(PG8_SA(1, 1), a1 + hstep, voffA);
            PG8_WAIT_V(8); PG8_WAIT_L(0); PG8_BAR; PG8_MMA(0, 0, At, B0); PG8_MMA(0, 1, At, B1); PG8_BAR; PG8_SCHED;
            PG8_LDA(At, 0, 1); PG8_STAGE(PG8_SB(0, 0), b2, voffB); PG8_STAGE(PG8_SB(0, 1), b2 + hstep, voffB); PG8_STAGE(PG8_SA(0, 0), a2, voffA);
            PG8_WAIT_V(8); PG8_WAIT_L(0); PG8_BAR; PG8_MMA(1, 0, At, B0); PG8_MMA(1, 1, At, B1); PG8_BAR; PG8_SCHED;
            PG8_LDB(B0, 1, 0); PG8_LDB(B1, 1, 1); PG8_SCHED; PG8_LDA(At, 1, 0); PG8_STAGE(PG8_SA(0, 1), a2 + hstep, voffA);
            PG8_WAIT_V(8); PG8_WAIT_L(0); PG8_BAR; PG8_MMA(0, 0, At, B0); PG8_MMA(0, 1, At, B1); PG8_BAR; PG8_SCHED;
            PG8_LDA(At, 1, 1); PG8_STAGE(PG8_SB(1, 0), b3, voffB); PG8_STAGE(PG8_SB(1, 1), b3 + hstep, voffB); PG8_STAGE(PG8_SA(1, 0), a3, voffA);
            PG8_WAIT_V(8); PG8_WAIT_L(0); PG8_BAR; PG8_MMA(1, 0, At, B0); PG8_MMA(1, 1, At, B1); PG8_BAR; PG8_SCHED;
        }
        if (wr == 0) PG8_BAR;
        epi_store(acc, cur, wr, wc, fr, fq);
        if (!has_next) break;
#pragma unroll
        for (int a = 0; a < 2; ++a)
#pragma unroll
            for (int b = 0; b < 2; ++b)
#pragma unroll
                for (int m = 0; m < 4; ++m)
#pragma unroll
                    for (int n = 0; n < 2; ++n) acc[a][b][m][n] = (f32x4){0.f, 0.f, 0.f, 0.f};
        cur = nxt; cA = nA; cB = nB; ++ui;
        if (wr == 1) PG8_BAR;
    }
    PG8_WAIT_V(0);
    PG8_BAR;
#undef PG8_SA
#undef PG8_SB
#undef PG8_STAGE
#undef PG8_LDA
#undef PG8_LDB
#undef PG8_MMA
#undef PG8_WAIT_V
#undef PG8_WAIT_L
#undef PG8_BAR
#undef PG8_SCHED
}
}

struct P {
    const float *x, *c, *ctx, *c_ctx, *ada_w, *ada_b, *pre_g, *post_g, *ffn_up, *ffn_conv, *ffn_down, *ab_w_in, *ab_qk_conv, *ab_gate_b, *ab_sgu_w, *ab_sgu_b,
                *ab_head_g, *ab_w_out, *ret_w_in, *ret_decay, *ret_head_g, *ret_w_out;
    float* out; unsigned char* ws;
};

constexpr int MC_S = 136;
constexpr int MC_OFF_V = 0, MC_OFF_RT = MC_OFF_V + 144 * MC_S * 2, MC_OFF_K = MC_OFF_RT + 144 * MC_S * 2;
static_assert(MC_OFF_K + 128 * MC_S * 2 <= LDS_BYTES - 64, "mlstm chunk LDS");
__device__ __forceinline__ void mlstm_chunk_item(const P& p, LAS unsigned char* lds, int bl, int h, int dir, const int tid0) {
    const int wave = __builtin_amdgcn_readfirstlane(tid0 >> 6);
    const bf16_t* QC = (const bf16_t*)(p.ws + OFF_QC); const bf16_t* KC = (const bf16_t*)(p.ws + OFF_KC); const bf16_t* VT = (const bf16_t*)(p.ws + OFF_VT0);
    bf16_t* RO = (bf16_t*)(p.ws + (dir ? OFF_RB : OFF_RF));
    const float* ROWT = (const float*)(p.ws + OFF_ROWT); const float* COLT = (const float*)(p.ws + OFF_COLT); const float* ENM = (const float*)(p.ws + OFF_ENM);
    LAS bf16_t* Vs = (LAS bf16_t*)(lds + MC_OFF_V); LAS bf16_t* RT = (LAS bf16_t*)(lds + MC_OFF_RT); LAS bf16_t* Ks = (LAS bf16_t*)(lds + MC_OFF_K);
    const size_t rowbase = (size_t)bl * LT;
    const size_t sbase = (size_t)((bl * 4 + h) * 2 + dir) * LT;
    f32x4 st[9];
#pragma unroll
    for (int mt = 0; mt < 9; ++mt) st[mt] = (f32x4){0.f, 0.f, 0.f, 0.f};
    __syncthreads();
    for (int idx = tid0; idx < 15 * MC_S / 2; idx += 512) ((LAS unsigned*)(Vs + 129 * MC_S))[idx] = 0u;
#define MC_J(pp) (dir == 0 ? (pp) : ((pp) < 256 ? 255 - (pp) : 2559 - (pp)))
#define MC_CJ(sx) (dir == 0 ? (sx) : ((sx) < 2 ? 1 - (sx) : 19 - (sx)))
    u32x4 pv[4], pk[4]; f32x4 cz[2]; bf16x8 qf[4];
    {
        int t0 = tid0; asm volatile("" : "+v"(t0)); const int tid = t0, lane = tid & 63, l15 = lane & 15, quad = lane >> 4, vpart = tid & 15;
        const int cj = MC_CJ(0); const size_t tok0 = rowbase + (size_t)cj * 128;
        const char* vbase = (const char*)(VT + (size_t)(h * 128) * TG + tok0);
        const unsigned voff = (unsigned)(tid >> 4) * (unsigned)(TG * 2) + (unsigned)vpart * 16u;
        const char* kbase = (const char*)(KC + tok0 * 512 + h * 128);
        const unsigned koff = (unsigned)(((tid >> 4) * 512 + vpart * 8) * 2);
#pragma unroll
        for (int i = 0; i < 4; ++i) pv[i] = *(const u32x4*)(vbase + (size_t)i * 32 * TG * 2 + voff);
#pragma unroll
        for (int i = 0; i < 4; ++i) pk[i] = *(const u32x4*)(kbase + (size_t)i * 32 * 512 * 2 + koff);
        cz[0] = *(const f32x4*)(COLT + sbase + cj * 128 + vpart * 8); cz[1] = *(const f32x4*)(COLT + sbase + cj * 128 + vpart * 8 + 4);
#pragma unroll
        for (int ks = 0; ks < 4; ++ks) qf[ks] = *(const bf16x8*)((const char*)(QC + tok0 * 512 + h * 128) + (unsigned)(((wave * 16 + l15) * 512 + quad * 8) * 2) + ks * 64);
    }
#pragma unroll 1
    for (int sidx = 0; sidx < 18; ++sidx) {
        const int cj = MC_CJ(sidx);
        const size_t tok0 = rowbase + (size_t)cj * 128;
        int tl = tid0; asm volatile("" : "+v"(tl));
        const int tid = tl, lane = tid & 63, l15 = lane & 15, quad = lane >> 4, vpart = tid & 15;
        const float Rend = ROWT[sbase + MC_J(128 * sidx + 127)];
        const float Rprev = sidx ? ROWT[sbase + MC_J(128 * sidx - 1)] : Rend;
        const int qpos = wave * 16 + l15;
        const float rtq = ROWT[sbase + cj * 128 + qpos];
        const float enq = ENM[sbase + cj * 128 + qpos];
        __syncthreads();
        {
            float zf[8];
            zf[0] = fast_exp2(cz[0][0] + Rend); zf[1] = fast_exp2(cz[0][1] + Rend); zf[2] = fast_exp2(cz[0][2] + Rend); zf[3] = fast_exp2(cz[0][3] + Rend);
            zf[4] = fast_exp2(cz[1][0] + Rend); zf[5] = fast_exp2(cz[1][1] + Rend); zf[6] = fast_exp2(cz[1][2] + Rend); zf[7] = fast_exp2(cz[1][3] + Rend);
#pragma unroll
            for (int i = 0; i < 4; ++i) {
                float f[8]; unpack8(pv[i], f);
                u32x4 w; w.x = pk2(f[0] * zf[0], f[1] * zf[1]); w.y = pk2(f[2] * zf[2], f[3] * zf[3]); w.z = pk2(f[4] * zf[4], f[5] * zf[5]); w.w = pk2(f[6] * zf[6], f[7] * zf[7]);
                *(LAS u32x4*)(Vs + ((tid >> 4) + 32 * i) * MC_S + vpart * 8) = w;
            }
            if (tid < 16) { u32x4 w; w.x = pk2(zf[0], zf[1]); w.y = pk2(zf[2], zf[3]); w.z = pk2(zf[4], zf[5]); w.w = pk2(zf[6], zf[7]); *(LAS u32x4*)(Vs + 128 * MC_S + vpart * 8) = w; }
#pragma unroll
            for (int i = 0; i < 4; ++i) *(LAS u32x4*)(Ks + ((tid >> 4) + 32 * i) * MC_S + vpart * 8) = pk[i];
        }
        const float rfq = fast_exp2(rtq - Rend);
        __syncthreads();
        f32x4 o[9];
        if (sidx) {
#pragma unroll
            for (int nt = 0; nt < 9; ++nt) {
                f32x4 acc = (f32x4){0.f, 0.f, 0.f, 0.f};
#pragma unroll
                for (int ks = 0; ks < 4; ++ks) { const bf16x8 b = *(const LAS bf16x8*)(RT + (nt * 16 + l15) * MC_S + ks * 32 + quad * 8);
                    acc = __builtin_amdgcn_mfma_f32_16x16x32_bf16(qf[ks], b, acc, 0, 0, 0); }
                o[nt] = acc;
            }
            const f32x4 rt4 = *(const f32x4*)(ROWT + sbase + cj * 128 + wave * 16 + quad * 4);
#pragma unroll
            for (int r = 0; r < 4; ++r) { const float cf = fast_exp2(rt4[r] - Rprev);
#pragma unroll
                for (int nt = 0; nt < 9; ++nt) o[nt][r] *= cf; }
        } else {
#pragma unroll
            for (int nt = 0; nt < 9; ++nt) o[nt] = (f32x4){0.f, 0.f, 0.f, 0.f};
        }
        f32x4 sT[8];
#pragma unroll
        for (int kt = 0; kt < 8; ++kt) {
            f32x4 sa = (f32x4){0.f, 0.f, 0.f, 0.f};
#pragma unroll
            for (int ks = 0; ks < 4; ++ks) { const bf16x8 a = *(const LAS bf16x8*)(Ks + (kt * 16 + l15) * MC_S + ks * 32 + quad * 8);
                sa = __builtin_amdgcn_mfma_f32_16x16x32_bf16(a, qf[ks], sa, 0, 0, 0); }
#pragma unroll
            for (int r = 0; r < 4; ++r) { const int kpos = kt * 16 + quad * 4 + r; const bool ok = dir ? (kpos >= qpos) : (kpos <= qpos); sa[r] = ok ? sa[r] * rfq : 0.f; }
            sT[kt] = sa;
        }
        if (sidx + 1 < 18) {
            const size_t tokn = rowbase + (size_t)MC_CJ(sidx + 1) * 128;
#pragma unroll
            for (int ks = 0; ks < 4; ++ks) qf[ks] = *(const bf16x8*)((const char*)(QC + tokn * 512 + h * 128) + (unsigned)((qpos * 512 + quad * 8) * 2) + ks * 64);
        }
#pragma unroll
        for (int i = 0; i < 4; ++i) {
            u32x4 pw; pw.x = cvt_pk_bf16(sT[2 * i][0], sT[2 * i][1]); pw.y = cvt_pk_bf16(sT[2 * i][2], sT[2 * i][3]);
            pw.z = cvt_pk_bf16(sT[2 * i + 1][0], sT[2 * i + 1][1]); pw.w = cvt_pk_bf16(sT[2 * i + 1][2], sT[2 * i + 1][3]);
            const bf16x8 pa = __builtin_bit_cast(bf16x8, pw);
#pragma unroll
            for (int nt = 0; nt < 9; ++nt) {
                const u32x2 lo = *(const LAS u32x2*)(Vs + (nt * 16 + l15) * MC_S + i * 32 + quad * 4);
                const u32x2 hi = *(const LAS u32x2*)(Vs + (nt * 16 + l15) * MC_S + i * 32 + 16 + quad * 4);
                u32x4 bw; bw.x = lo.x; bw.y = lo.y; bw.z = hi.x; bw.w = hi.y;
                o[nt] = __builtin_amdgcn_mfma_f32_16x16x32_bf16(pa, __builtin_bit_cast(bf16x8, bw), o[nt], 0, 0, 0);
            }
        }
        {
            const f32x4 en4 = *(const f32x4*)(ENM + sbase + cj * 128 + wave * 16 + quad * 4);
#pragma unroll
            for (int r = 0; r < 4; ++r) {
                const float den = shfl_idx(o[8][r], quad * 16);
                const float inv = 1.0f / fmaxf(fabsf(den), en4[r]);
                bf16_t* orow = (bf16_t*)((char*)(RO + tok0 * 512 + h * 128) + (unsigned)(((wave * 16 + quad * 4 + r) * 512 + l15) * 2));
#pragma unroll
                for (int nt = 0; nt < 8; ++nt) orow[nt * 16] = (bf16_t)f2bf(o[nt][r] * inv);
            }
        }
        (void)enq;
        __syncthreads();
        if (sidx + 1 < 18) {
            const int cjn = MC_CJ(sidx + 1); const size_t tokn = rowbase + (size_t)cjn * 128;
            const char* vbase = (const char*)(VT + (size_t)(h * 128) * TG + tokn);
            const unsigned voff = (unsigned)(tid >> 4) * (unsigned)(TG * 2) + (unsigned)vpart * 16u;
            const char* kbase = (const char*)(KC + tokn * 512 + h * 128);
            const unsigned koff = (unsigned)(((tid >> 4) * 512 + vpart * 8) * 2);
#pragma unroll
            for (int i = 0; i < 4; ++i) pv[i] = *(const u32x4*)(vbase + (size_t)i * 32 * TG * 2 + voff);
#pragma unroll
            for (int i = 0; i < 4; ++i) pk[i] = *(const u32x4*)(kbase + (size_t)i * 32 * 512 * 2 + koff);
            cz[0] = *(const f32x4*)(COLT + sbase + cjn * 128 + vpart * 8); cz[1] = *(const f32x4*)(COLT + sbase + cjn * 128 + vpart * 8 + 4);
        }
        {
            const float decay = fast_exp2(Rend - Rprev);
#pragma unroll
            for (int mt = 0; mt < 9; ++mt) st[mt] = st[mt] * decay;
#pragma unroll
            for (int ks = 0; ks < 4; ++ks) {
                u32x4 bw;
                { const LAS bf16_t* kp = Ks + (ks * 32 + quad * 8) * MC_S + wave * 16 + l15;
                  bw.x = (unsigned)kp[0 * MC_S] | ((unsigned)kp[1 * MC_S] << 16); bw.y = (unsigned)kp[2 * MC_S] | ((unsigned)kp[3 * MC_S] << 16);
                  bw.z = (unsigned)kp[4 * MC_S] | ((unsigned)kp[5 * MC_S] << 16); bw.w = (unsigned)kp[6 * MC_S] | ((unsigned)kp[7 * MC_S] << 16); }
                const bf16x8 b = __builtin_bit_cast(bf16x8, bw);
#pragma unroll
                for (int mt = 0; mt < 9; ++mt) { const bf16x8 a = *(const LAS bf16x8*)(Vs + (mt * 16 + l15) * MC_S + ks * 32 + quad * 8);
                    st[mt] = __builtin_amdgcn_mfma_f32_16x16x32_bf16(a, b, st[mt], 0, 0, 0); }
            }
#pragma unroll
            for (int mt = 0; mt < 9; ++mt)
#pragma unroll
                for (int r = 0; r < 4; ++r) RT[(mt * 16 + quad * 4 + r) * MC_S + wave * 16 + l15] = (bf16_t)f2bf(st[mt][r]);
        }
    }
#undef MC_CJ
#undef MC_J
}
__device__ __forceinline__ void mlstm_post_row(const P& p, int r, int lane) {
    const bf16_t* RF = (const bf16_t*)(p.ws + OFF_RF) + (size_t)r * 512; const bf16_t* RB = (const bf16_t*)(p.ws + OFF_RB) + (size_t)r * 512;
    const bf16_t* OG = (const bf16_t*)(p.ws + OFF_PN) + (size_t)r * 2048 + 1024;
    bf16_t* CAT = (bf16_t*)(p.ws + OFF_H) + (size_t)r * 1024 + 512;
    const int c0 = lane * 8;
    const f32x4 h0 = *(const f32x4*)(p.ab_head_g + c0), h1 = *(const f32x4*)(p.ab_head_g + c0 + 4);
    float a[2][8];
#pragma unroll
    for (int q = 0; q < 2; ++q) {
        float b[8], g[8]; unpack8(__builtin_nontemporal_load((const u32x4*)(RF + q * 512 + c0)), a[q]); unpack8(__builtin_nontemporal_load((const u32x4*)(RB + q * 512 + c0)), b);
        unpack8(__builtin_nontemporal_load((const u32x4*)(OG + q * 2048 + c0)), g);
#pragma unroll
        for (int i = 0; i < 8; ++i) a[q][i] = (a[q][i] + b[i]) * g[i];
    }
#pragma unroll
    for (int q = 0; q < 2; ++q) {
        float s = 0.f;
#pragma unroll
        for (int i = 0; i < 8; ++i) s += a[q][i];
        s += shfl_xor_l(s, 1, lane); s += shfl_xor_l(s, 2, lane); s += shfl_xor_l(s, 4, lane); s += shfl_xor_l(s, 8, lane);
        const float mean = s * (1.0f / 128.0f); float qq = 0.f;
#pragma unroll
        for (int i = 0; i < 8; ++i) { a[q][i] -= mean; qq += a[q][i] * a[q][i]; }
        qq += shfl_xor_l(qq, 1, lane); qq += shfl_xor_l(qq, 2, lane); qq += shfl_xor_l(qq, 4, lane); qq += shfl_xor_l(qq, 8, lane);
        const float rstd = rsqrtf(qq * (1.0f / 128.0f) + 1e-6f);
        u32x4 w; w.x = pk2(a[q][0] * rstd * h0[0], a[q][1] * rstd * h0[1]); w.y = pk2(a[q][2] * rstd * h0[2], a[q][3] * rstd * h0[3]);
        w.z = pk2(a[q][4] * rstd * h1[0], a[q][5] * rstd * h1[1]); w.w = pk2(a[q][6] * rstd * h1[2], a[q][7] * rstd * h1[3]);
        *(u32x4*)(CAT + q * 1024 + c0) = w;
    }
}

__device__ __forceinline__ void sgu_item(const P& p, int bl, int chunk, int g, const int tid) {
    const int wave = __builtin_amdgcn_readfirstlane(tid >> 6), lane = tid & 63, l15 = lane & 15, quad = lane >> 4;
    const bf16_t* SW = (const bf16_t*)(p.ws + OFF_SGUW); const bf16_t* VT = (const bf16_t*)(p.ws + OFF_VT0);
    const bf16_t* PN = (const bf16_t*)(p.ws + OFF_PN); bf16_t* CAT = (bf16_t*)(p.ws + OFF_H);
    const size_t tok0 = (size_t)bl * LT + chunk * 128;
    bf16x8 af[4];
#pragma unroll
    for (int ks = 0; ks < 4; ++ks) af[ks] = *(const bf16x8*)(SW + (size_t)(g * 128 + wave * 16 + l15) * 128 + ks * 32 + quad * 8);
#pragma unroll 2
    for (int nt = 0; nt < 8; ++nt) {
        f32x4 acc = (f32x4){0.f, 0.f, 0.f, 0.f};
#pragma unroll
        for (int ks = 0; ks < 4; ++ks) {
            const bf16x8 b = *(const bf16x8*)(VT + (size_t)(512 + g * 128 + nt * 16 + l15) * TG + tok0 + ks * 32 + quad * 8);
            acc = __builtin_amdgcn_mfma_f32_16x16x32_bf16(af[ks], b, acc, 0, 0, 0);
        }
#pragma unroll
        for (int r = 0; r < 4; ++r) {
            const int pp = wave * 16 + quad * 4 + r; const size_t tok = tok0 + pp;
            const float uu = bf2f(PN[tok * 2048 + 1536 + g * 128 + nt * 16 + l15]);
            CAT[tok * 1024 + g * 128 + nt * 16 + l15] = (bf16_t)f2bf((acc[r] + p.ab_sgu_b[g * 128 + pp]) * uu);
        }
    }
}

constexpr int RC_VS = 136, RC_RS = 264, RC_KS = 264, RC_KTS = 136;
constexpr int RC_OFF_V = 0, RC_OFF_RT = RC_OFF_V + 128 * RC_VS * 2, RC_OFF_KT = RC_OFF_RT, RC_OFF_KH = RC_OFF_KT + 256 * RC_KTS * 2;
static_assert(RC_OFF_KH + 64 * RC_KS * 2 <= LDS_BYTES - 64, "retention LDS");
static_assert(RC_OFF_RT + 128 * RC_RS * 2 <= RC_OFF_KH, "retention LDS overlay");
__device__ __forceinline__ void ret_chunk_item(const P& p, LAS unsigned char* lds, int bl, int h, int vs, const int tid) {
    const int wave = __builtin_amdgcn_readfirstlane(tid >> 6), lane = tid & 63, l15 = lane & 15, quad = lane >> 4;
    const bf16_t* Q1 = (const bf16_t*)(p.ws + OFF_Q1); const bf16_t* K1 = (const bf16_t*)(p.ws + OFF_K1); const bf16_t* VT = (const bf16_t*)(p.ws + OFF_VT1);
    const bf16_t* K1T = (const bf16_t*)(p.ws + OFF_K1T);
    LAS bf16_t* Vs = (LAS bf16_t*)(lds + RC_OFF_V); LAS bf16_t* RT = (LAS bf16_t*)(lds + RC_OFF_RT);
    LAS bf16_t* KTs = (LAS bf16_t*)(lds + RC_OFF_KT); LAS bf16_t* KH = (LAS bf16_t*)(lds + RC_OFF_KH);
    const size_t rowbase = (size_t)bl * LT;
#define RC_CJ(sx) (dir == 0 ? (sx) : ((sx) < 2 ? 1 - (sx) : 19 - (sx)))
#pragma unroll 1
    for (int dir = 0; dir < 2; ++dir) {
        bf16_t* RO = (bf16_t*)(p.ws + (dir ? OFF_MRG2 : OFF_MRG));
        const float dl = p.ret_decay[dir * 4 + h];
        const float lg2 = logsig(dl) * LOG2E;
        const float g128 = fast_exp2(lg2 * 128.0f);
        f32x4 st[2][8];
#pragma unroll
        for (int mt = 0; mt < 2; ++mt)
#pragma unroll
            for (int nt = 0; nt < 8; ++nt) st[mt][nt] = (f32x4){0.f, 0.f, 0.f, 0.f};
        u32x4 pv[4], pk[4]; bf16x8 qf[8];
        {
            int t0 = tid; asm volatile("" : "+v"(t0)); const int tid = t0;
            const size_t tok0 = rowbase + (size_t)RC_CJ(0) * 128;
            const u32x4* vp = (const u32x4*)((const char*)(VT + (size_t)(h * 512 + vs * 128) * TG + tok0) + ((unsigned)(tid >> 2) * (unsigned)(TG * 2) + (unsigned)(tid & 3) * 64u));
            const u32x4* kp = (const u32x4*)((const char*)(K1 + tok0 * 1024 + h * 256) + (unsigned)(((tid >> 3) * 1024 + (tid & 7) * 32) * 2));
#pragma unroll
            for (int i = 0; i < 4; ++i) pv[i] = vp[i];
#pragma unroll
            for (int i = 0; i < 4; ++i) pk[i] = kp[i];
        }
#pragma unroll 1
        for (int sidx = 0; sidx < 18; ++sidx) {
            const int cj = RC_CJ(sidx);
            const bool is_lat = cj >= 2;
            const size_t tok0 = rowbase + (size_t)cj * 128;
            int tl = tid; asm volatile("" : "+v"(tl));
            const int tid = tl, lane = tid & 63, l15 = lane & 15, quad = lane >> 4, vpart = tid & 15;
            const unsigned ktoff = (unsigned)(tid >> 2) * (unsigned)(TG * 2) + (unsigned)(tid & 3) * 64u;
            const unsigned khoff = (unsigned)(((tid >> 3) * 1024 + (tid & 7) * 32) * 2);
            const int qpos = wave * 16 + l15;
            __syncthreads();
            {
                const int p0 = (tid & 3) * 32;
                float z = fast_exp2(lg2 * (float)(dir ? p0 : 127 - p0));
                const float zstep = fast_exp2(dir ? lg2 : -lg2);
#pragma unroll
                for (int i = 0; i < 4; ++i) {
                    float f[8]; unpack8(pv[i], f);
#pragma unroll
                    for (int e = 0; e < 8; ++e) { f[e] *= z; z *= zstep; }
                    u32x4 w; w.x = pk2(f[0], f[1]); w.y = pk2(f[2], f[3]); w.z = pk2(f[4], f[5]); w.w = pk2(f[6], f[7]);
                    *(LAS u32x4*)(Vs + (tid >> 2) * RC_VS + p0 + i * 8) = w;
                }
#pragma unroll
                for (int i = 0; i < 4; ++i) *(LAS u32x4*)(KH + (tid >> 3) * RC_KS + (tid & 7) * 32 + i * 8) = pk[i];
            }
            __syncthreads();
            f32x4 o[8];
#pragma unroll 1
            for (int hf = 0; hf < 2; ++hf) {
                if (hf == 0) {
#pragma unroll
                    for (int i = 0; i < 4; ++i) pk[i] = ((const u32x4*)((const char*)(K1 + (tok0 + 64) * 1024 + h * 256) + khoff))[i];
                } else {
                    __syncthreads();
#pragma unroll
                    for (int i = 0; i < 4; ++i) *(LAS u32x4*)(KH + (tid >> 3) * RC_KS + (tid & 7) * 32 + i * 8) = pk[i];
                    __syncthreads();
                    if (sidx + 1 < 18) {
                        const size_t tokn = rowbase + (size_t)RC_CJ(sidx + 1) * 128;
#pragma unroll
                        for (int i = 0; i < 4; ++i) pk[i] = ((const u32x4*)((const char*)(K1 + tokn * 1024 + h * 256) + khoff))[i];
                    }
                }
                if (is_lat) {
                    if (hf == 0) {
#pragma unroll
                        for (int nt = 0; nt < 8; ++nt) {
                            f32x4 acc = (f32x4){0.f, 0.f, 0.f, 0.f};
#pragma unroll
                            for (int ks = 0; ks < 8; ++ks) { const bf16x8 b = *(const LAS bf16x8*)(RT + (nt * 16 + l15) * RC_RS + ks * 32 + quad * 8);
                                acc = __builtin_amdgcn_mfma_f32_16x16x32_bf16(qf[ks], b, acc, 0, 0, 0); }
#pragma unroll
                            for (int r = 0; r < 4; ++r) { const int pos = wave * 16 + quad * 4 + r; acc[r] *= fast_exp2(lg2 * (float)((dir ? 127 - pos : pos) + 1)); }
                            o[nt] = acc;
                            __builtin_amdgcn_sched_barrier(0);
                        }
                    }
                    f32x4 sT[4];
#pragma unroll
                    for (int kt = 0; kt < 4; ++kt) {
                        f32x4 sa = (f32x4){0.f, 0.f, 0.f, 0.f};
#pragma unroll
                        for (int ks = 0; ks < 8; ++ks) { const bf16x8 a = *(const LAS bf16x8*)(KH + (kt * 16 + l15) * RC_KS + ks * 32 + quad * 8);
                            sa = __builtin_amdgcn_mfma_f32_16x16x32_bf16(a, qf[ks], sa, 0, 0, 0); }
                        sT[kt] = sa;
                        __builtin_amdgcn_sched_barrier(0);
                    }
                    if (hf == 1 && sidx + 1 < 18 && RC_CJ(sidx + 1) >= 2) {
                        const size_t tokn = rowbase + (size_t)RC_CJ(sidx + 1) * 128;
#pragma unroll
                        for (int ks = 0; ks < 8; ++ks) qf[ks] = *(const bf16x8*)((const char*)(Q1 + tokn * 1024 + h * 256) + (unsigned)((qpos * 1024 + quad * 8) * 2) + ks * 64);
                    }
                    const float rsq = fast_exp2(lg2 * (float)((dir ? 127 - qpos : qpos) - 127));
#pragma unroll
                    for (int kt = 0; kt < 4; ++kt)
#pragma unroll
                        for (int r = 0; r < 4; ++r) { const int kpos = hf * 64 + kt * 16 + quad * 4 + r;
                            const bool ok = dir ? (kpos >= qpos) : (kpos <= qpos);
                            sT[kt][r] = ok ? sT[kt][r] * rsq : 0.f; }
#pragma unroll
                    for (int i = 0; i < 2; ++i) {
                        u32x4 pw; pw.x = cvt_pk_bf16(sT[2 * i][0], sT[2 * i][1]); pw.y = cvt_pk_bf16(sT[2 * i][2], sT[2 * i][3]);
                        pw.z = cvt_pk_bf16(sT[2 * i + 1][0], sT[2 * i + 1][1]); pw.w = cvt_pk_bf16(sT[2 * i + 1][2], sT[2 * i + 1][3]);
                        const bf16x8 pa = __builtin_bit_cast(bf16x8, pw);
#pragma unroll
                        for (int nt = 0; nt < 8; ++nt) {
                            const u32x2 lo = *(const LAS u32x2*)(Vs + (nt * 16 + l15) * RC_VS + hf * 64 + i * 32 + quad * 4);
                            const u32x2 hi = *(const LAS u32x2*)(Vs + (nt * 16 + l15) * RC_VS + hf * 64 + i * 32 + 16 + quad * 4);
                            u32x4 bw; bw.x = lo.x; bw.y = lo.y; bw.z = hi.x; bw.w = hi.y;
                            o[nt] = __builtin_amdgcn_mfma_f32_16x16x32_bf16(pa, __builtin_bit_cast(bf16x8, bw), o[nt], 0, 0, 0);
                        }
                    }
                    if (hf == 1) {
#pragma unroll
                        for (int r = 0; r < 4; ++r) {
                            bf16_t* orow = (bf16_t*)((char*)(RO + ((size_t)bl * SEQ + (cj - 2) * 128) * 2048 + h * 512 + vs * 128) + (unsigned)(((wave * 16 + quad * 4 + r) * 2048 + l15) * 2));
#pragma unroll
                            for (int nt = 0; nt < 8; ++nt) orow[nt * 16] = (bf16_t)f2bf(o[nt][r]);
                        }
                    }
                } else if (hf == 1 && sidx + 1 < 18 && RC_CJ(sidx + 1) >= 2) {
                    const size_t tokn = rowbase + (size_t)RC_CJ(sidx + 1) * 128;
#pragma unroll
                    for (int ks = 0; ks < 8; ++ks) qf[ks] = *(const bf16x8*)((const char*)(Q1 + tokn * 1024 + h * 256) + (unsigned)((qpos * 1024 + quad * 8) * 2) + ks * 64);
                }
                if (hf == 1 && sidx + 1 < 18) {
                    const size_t tokn = rowbase + (size_t)RC_CJ(sidx + 1) * 128;
                    const char* vbase = (const char*)(VT + (size_t)(h * 512 + vs * 128) * TG + tokn);
#pragma unroll
                    for (int i = 0; i < 4; ++i) pv[i] = ((const u32x4*)(vbase + ktoff))[i];
                }
                if (hf == 0) {
#pragma unroll
                    for (int mt = 0; mt < 2; ++mt)
#pragma unroll
                        for (int nt = 0; nt < 8; ++nt) st[mt][nt] = st[mt][nt] * g128;
                }
#pragma unroll
                for (int ks2 = 0; ks2 < 2; ++ks2) {
#pragma unroll
                    for (int mt = 0; mt < 2; ++mt) {
                        u32x4 aw;
                        { const LAS bf16_t* kp = KH + (ks2 * 32 + quad * 8) * RC_KS + wave * 32 + mt * 16 + l15;
                          aw.x = (unsigned)kp[0 * RC_KS] | ((unsigned)kp[1 * RC_KS] << 16); aw.y = (unsigned)kp[2 * RC_KS] | ((unsigned)kp[3 * RC_KS] << 16);
                          aw.z = (unsigned)kp[4 * RC_KS] | ((unsigned)kp[5 * RC_KS] << 16); aw.w = (unsigned)kp[6 * RC_KS] | ((unsigned)kp[7 * RC_KS] << 16); }
                        const bf16x8 a = __builtin_bit_cast(bf16x8, aw);
#pragma unroll
                        for (int nt = 0; nt < 8; ++nt) { const bf16x8 b = *(const LAS bf16x8*)(Vs + (nt * 16 + l15) * RC_VS + hf * 64 + ks2 * 32 + quad * 8);
                            st[mt][nt] = __builtin_amdgcn_mfma_f32_16x16x32_bf16(a, b, st[mt][nt], 0, 0, 0); }
                        __builtin_amdgcn_sched_barrier(0);
                    }
                }
            }
#pragma unroll
            for (int mt = 0; mt < 2; ++mt)
#pragma unroll
                for (int nt = 0; nt < 8; ++nt) { u32x2 w; w.x = cvt_pk_bf16(st[mt][nt][0], st[mt][nt][1]); w.y = cvt_pk_bf16(st[mt][nt][2], st[mt][nt][3]);
                    *(LAS u32x2*)(RT + (nt * 16 + l15) * RC_RS + wave * 32 + mt * 16 + quad * 4) = w; }
        }
    }
#undef RC_CJ
}
__device__ __forceinline__ void ret_post_row(const P& p, int rl, int lane) {
    bf16_t* row = (bf16_t*)(p.ws + OFF_MRG) + (size_t)rl * 2048;
    const bf16_t* row2 = (const bf16_t*)(p.ws + OFF_MRG2) + (size_t)rl * 2048;
    const int bl = rl / SEQ, t = rl % SEQ;
    const bf16_t* grow = (const bf16_t*)(p.ws + OFF_G1) + ((size_t)bl * LT + 256 + t) * 2048;
#pragma unroll
    for (int hh = 0; hh < 4; ++hh) {
        const int c0 = hh * 512 + lane * 8;
        float v[8], v2[8], gv[8]; unpack8(__builtin_nontemporal_load((const u32x4*)(row + c0)), v); unpack8(__builtin_nontemporal_load((const u32x4*)(row2 + c0)), v2); unpack8(__builtin_nontemporal_load((const u32x4*)(grow + c0)), gv);
#pragma unroll
        for (int i = 0; i < 8; ++i) v[i] += v2[i];
        float s = 0.f;
#pragma unroll
        for (int i = 0; i < 8; ++i) s += v[i];
        const float mean = wave_sum(s, lane) * (1.0f / 512.0f);
        float q = 0.f;
#pragma unroll
        for (int i = 0; i < 8; ++i) { v[i] -= mean; q += v[i] * v[i]; }
        const float rstd = rsqrtf(wave_sum(q, lane) * (1.0f / 512.0f) + 1e-6f);
        const f32x4 h0 = *(const f32x4*)(p.ret_head_g + c0), h1 = *(const f32x4*)(p.ret_head_g + c0 + 4);
        u32x4 w; w.x = pk2(v[0] * rstd * h0[0] * gv[0], v[1] * rstd * h0[1] * gv[1]); w.y = pk2(v[2] * rstd * h0[2] * gv[2], v[3] * rstd * h0[3] * gv[3]);
        w.z = pk2(v[4] * rstd * h1[0] * gv[4], v[5] * rstd * h1[1] * gv[5]); w.w = pk2(v[6] * rstd * h1[2] * gv[6], v[7] * rstd * h1[3] * gv[7]);
        *(u32x4*)(row + c0) = w;
    }
}

template <bool GATES>
__device__ __forceinline__ void row_pass(const float* xsrc, const bf16_t* y, float* xdst, bf16_t* hrow, const float* postg, const float* mg,
                                         const float* preg, const float* msh, const float* msc, int lane,
                                         const LAS float* wgT = nullptr, const float* gate_b = nullptr, float* grow = nullptr) {
    f32x4 v[4];
#pragma unroll
    for (int j = 0; j < 4; ++j) v[j] = __builtin_nontemporal_load((const f32x4*)(xsrc + lane * 4 + 256 * j));
    if (y) {
        f32x4 yv[4]; float ss = 0.f;
#pragma unroll
        for (int j = 0; j < 4; ++j) { const u32x2 w = __builtin_nontemporal_load((const u32x2*)(y + lane * 4 + 256 * j)); yv[j] = (f32x4){bflo(w.x), bfhi(w.x), bflo(w.y), bfhi(w.y)};
            ss += (yv[j][0] * yv[j][0] + yv[j][1] * yv[j][1]) + (yv[j][2] * yv[j][2] + yv[j][3] * yv[j][3]); }
        ss = wave_sum(ss, lane);
        const float ry = rsqrtf(ss * (1.0f / 1024.0f) + 1e-6f);
#pragma unroll
        for (int j = 0; j < 4; ++j) { const f32x4 pg = *(const f32x4*)(postg + lane * 4 + 256 * j), gg = *(const f32x4*)(mg + lane * 4 + 256 * j);
            v[j] = v[j] + gg * (yv[j] * ry * pg); }
        if (xdst) {
#pragma unroll
            for (int j = 0; j < 4; ++j) __builtin_nontemporal_store(v[j], (f32x4*)(xdst + lane * 4 + 256 * j));
        }
    }
    if (hrow) {
        float ss = 0.f;
#pragma unroll
        for (int j = 0; j < 4; ++j) ss += (v[j][0] * v[j][0] + v[j][1] * v[j][1]) + (v[j][2] * v[j][2] + v[j][3] * v[j][3]);
        ss = wave_sum(ss, lane);
        const float rx = rsqrtf(ss * (1.0f / 1024.0f) + 1e-6f);
#pragma unroll
        for (int j = 0; j < 4; ++j) { const f32x4 pr = *(const f32x4*)(preg + lane * 4 + 256 * j), sh = *(const f32x4*)(msh + lane * 4 + 256 * j), sc = *(const f32x4*)(msc + lane * 4 + 256 * j);
            const f32x4 hv = v[j] * rx * pr * (sc + 1.0f) + sh;
            if (GATES) v[j] = hv;
            u32x2 w; w.x = pk2(hv[0], hv[1]); w.y = pk2(hv[2], hv[3]);
            __builtin_nontemporal_store(w, (u32x2*)(hrow + lane * 4 + 256 * j)); }
        if (GATES) {
            float mine = 0.f;
#pragma unroll 2
            for (int g = 0; g < 16; ++g) {
                float s = 0.f;
#pragma unroll
                for (int j = 0; j < 4; ++j) { const f32x4 w = *(const LAS f32x4*)(wgT + g * 1024 + lane * 4 + 256 * j);
                    s += (v[j][0] * w[0] + v[j][1] * w[1]) + (v[j][2] * w[2] + v[j][3] * w[3]); }
                s = wave_sum(s, lane);
                if (lane == g) mine = s;
            }
            if (lane < 16) grow[lane] = mine + gate_b[lane];
        }
    }
}

template <bool GATES>
__device__ __forceinline__ void row_pass2(const float* xsrc, const bf16_t* y, float* xdst, bf16_t* hrow, const float* postg, const float* mg,
                                          const float* preg, const float* msh, const float* msc, int lane,
                                          const LAS float* wgT = nullptr, const float* gate_b = nullptr, float* grow = nullptr) {
    f32x4 v[2][4];
#pragma unroll
    for (int q = 0; q < 2; ++q)
#pragma unroll
        for (int j = 0; j < 4; ++j) v[q][j] = __builtin_nontemporal_load((const f32x4*)(xsrc + q * 1024 + lane * 4 + 256 * j));
    if (y) {
        f32x4 yv[2][4]; float ss[2] = {0.f, 0.f};
#pragma unroll
        for (int q = 0; q < 2; ++q)
#pragma unroll
            for (int j = 0; j < 4; ++j) { const u32x2 w = __builtin_nontemporal_load((const u32x2*)(y + q * 1024 + lane * 4 + 256 * j)); yv[q][j] = (f32x4){bflo(w.x), bfhi(w.x), bflo(w.y), bfhi(w.y)};
                ss[q] += (yv[q][j][0] * yv[q][j][0] + yv[q][j][1] * yv[q][j][1]) + (yv[q][j][2] * yv[q][j][2] + yv[q][j][3] * yv[q][j][3]); }
        ss[0] = wave_sum(ss[0], lane); ss[1] = wave_sum(ss[1], lane);
        const float ry0 = rsqrtf(ss[0] * (1.0f / 1024.0f) + 1e-6f), ry1 = rsqrtf(ss[1] * (1.0f / 1024.0f) + 1e-6f);
#pragma unroll
        for (int j = 0; j < 4; ++j) { const f32x4 pg = *(const f32x4*)(postg + lane * 4 + 256 * j), gg = *(const f32x4*)(mg + lane * 4 + 256 * j);
            v[0][j] = v[0][j] + gg * (yv[0][j] * ry0 * pg); v[1][j] = v[1][j] + gg * (yv[1][j] * ry1 * pg); }
        if (xdst) {
#pragma unroll
            for (int q = 0; q < 2; ++q)
#pragma unroll
                for (int j = 0; j < 4; ++j) __builtin_nontemporal_store(v[q][j], (f32x4*)(xdst + q * 1024 + lane * 4 + 256 * j));
        }
    }
    if (hrow) {
        float ss[2] = {0.f, 0.f};
#pragma unroll
        for (int q = 0; q < 2; ++q)
#pragma unroll
            for (int j = 0; j < 4; ++j) ss[q] += (v[q][j][0] * v[q][j][0] + v[q][j][1] * v[q][j][1]) + (v[q][j][2] * v[q][j][2] + v[q][j][3] * v[q][j][3]);
        ss[0] = wave_sum(ss[0], lane); ss[1] = wave_sum(ss[1], lane);
        const float rx[2] = {rsqrtf(ss[0] * (1.0f / 1024.0f) + 1e-6f), rsqrtf(ss[1] * (1.0f / 1024.0f) + 1e-6f)};
#pragma unroll
        for (int j = 0; j < 4; ++j) { const f32x4 pr = *(const f32x4*)(preg + lane * 4 + 256 * j), sh = *(const f32x4*)(msh + lane * 4 + 256 * j), sc = *(const f32x4*)(msc + lane * 4 + 256 * j);
#pragma unroll
            for (int q = 0; q < 2; ++q) {
                const f32x4 hv = v[q][j] * rx[q] * pr * (sc + 1.0f) + sh;
                if (GATES) v[q][j] = hv;
                u32x2 w; w.x = pk2(hv[0], hv[1]); w.y = pk2(hv[2], hv[3]);
                __builtin_nontemporal_store(w, (u32x2*)(hrow + q * 1024 + lane * 4 + 256 * j)); } }
        if (GATES) {
            float mine0 = 0.f, mine1 = 0.f;
#pragma unroll 2
            for (int g = 0; g < 16; ++g) {
                float s0 = 0.f, s1 = 0.f;
#pragma unroll
                for (int j = 0; j < 4; ++j) { const f32x4 w = *(const LAS f32x4*)(wgT + g * 1024 + lane * 4 + 256 * j);
                    s0 += (v[0][j][0] * w[0] + v[0][j][1] * w[1]) + (v[0][j][2] * w[2] + v[0][j][3] * w[3]);
                    s1 += (v[1][j][0] * w[0] + v[1][j][1] * w[1]) + (v[1][j][2] * w[2] + v[1][j][3] * w[3]); }
                s0 = wave_sum(s0, lane); s1 = wave_sum(s1, lane);
                if (lane == g) { mine0 = s0; mine1 = s1; }
            }
            if (lane < 16) { grow[lane] = mine0 + gate_b[lane]; grow[16 + lane] = mine1 + gate_b[lane]; }
        }
    }
}

__device__ __forceinline__ void transpose_item(const float* W, int ldsrc, int K, bf16_t* WT, int nblk, LAS float* scr, int item, int lane) {
    const int kb = item / nblk, nb = item % nblk, k0 = 64 * kb, n0 = 32 * nb;
#pragma unroll 8
    for (int i = 0; i < 32; ++i) { const int kk = 2 * i + (lane >> 5); scr[kk * 33 + (lane & 31)] = W[(size_t)(k0 + kk) * ldsrc + n0 + (lane & 31)]; }
    LDS_WAIT();
    const int c = lane & 7;
#pragma unroll
    for (int j = 0; j < 4; ++j) { const int n = (lane >> 3) + 8 * j; const LAS float* s = scr + (8 * c) * 33 + n;
        u32x4 o; o.x = pk2(s[0 * 33], s[1 * 33]); o.y = pk2(s[2 * 33], s[3 * 33]); o.z = pk2(s[4 * 33], s[5 * 33]); o.w = pk2(s[6 * 33], s[7 * 33]);
        *(u32x4*)(WT + (size_t)(n0 + n) * K + k0 + 8 * c) = o; }
    LDS_WAIT();
}

__device__ __forceinline__ void ada_item(const P& p, LAS unsigned char* lds, int it, const int tid) {
    const int col = tid & 63, kg = __builtin_amdgcn_readfirstlane(tid >> 6);
    const int l = it / 96, n0 = (it % 96) * 64;
    LAS float* S = (LAS float*)lds;
    float acc[36];
#pragma unroll
    for (int r = 0; r < 36; ++r) acc[r] = 0.f;
    const float* W = p.ada_w + (size_t)l * 1024 * 6144;
#pragma unroll 1
    for (int kh = 0; kh < 2; ++kh) {
        __syncthreads();
        for (int r = 0; r < 36; ++r) {
            float sv = 0.f;
            if (r < 32) sv = silu_f(p.c[r * 1024 + kh * 512 + tid]); else if (r == 32) sv = silu_f(p.c_ctx[kh * 512 + tid]);
            S[tid * 36 + r] = sv;
        }
        __syncthreads();
#pragma unroll 2
        for (int kk = 0; kk < 64; ++kk) {
            const int kl = kg * 64 + kk;
            const float w = W[(size_t)(kh * 512 + kl) * 6144 + n0 + col];
#pragma unroll
            for (int r4 = 0; r4 < 9; ++r4) { const f32x4 s = *(const LAS f32x4*)(S + kl * 36 + r4 * 4);
                acc[r4 * 4 + 0] += s[0] * w; acc[r4 * 4 + 1] += s[1] * w; acc[r4 * 4 + 2] += s[2] * w; acc[r4 * 4 + 3] += s[3] * w; }
        }
    }
    __syncthreads();
    LAS float* R = (LAS float*)lds;
#pragma unroll
    for (int r = 0; r < 36; ++r) R[(kg * 36 + r) * 64 + col] = acc[r];
    __syncthreads();
    float* MOD = (float*)(p.ws + OFF_MOD);
    for (int idx = tid; idx < 33 * 64; idx += 512) {
        const int r = idx >> 6, cc = idx & 63; float s = 0.f;
#pragma unroll
        for (int k8 = 0; k8 < 8; ++k8) s += R[(k8 * 36 + r) * 64 + cc];
        MOD[(size_t)(l * 33 + r) * 6144 + n0 + cc] = s + p.ada_b[l * 6144 + n0 + cc];
    }
    __syncthreads();
}

__device__ __forceinline__ void prologue(const P& p, LAS unsigned char* lds, const int tid) {
    const int wave = __builtin_amdgcn_readfirstlane(tid >> 6), lane = tid & 63;
    const int G = gridDim.x;
    for (int it = blockIdx.x; it < 192; it += G) ada_item(p, lds, it, tid);
    __syncthreads();
    LAS float* scr = (LAS float*)(lds + wave * 16384);
    const int gw = blockIdx.x * 8 + wave, NGW = G * 8;
    unsigned char* ws = p.ws;
#define SEG(SRC, LDSRC, KK, NC, DST) { const int nblk = (NC) / 32, nit = ((KK) / 64) * nblk; \
        for (int it = gw; it < nit; it += NGW) transpose_item((SRC), (LDSRC), (KK), (DST), nblk, scr, it, lane); }
    SEG(p.ab_w_in + 0,    3088, 1024, 512, (bf16_t*)(ws + OFF_W0N) + (size_t)0 * 1024)
    SEG(p.ab_w_in + 1040, 3088, 1024, 512, (bf16_t*)(ws + OFF_W0N) + (size_t)512 * 1024)
    SEG(p.ab_w_in + 1552, 3088, 1024, 512, (bf16_t*)(ws + OFF_W0N) + (size_t)1024 * 1024)
    SEG(p.ab_w_in + 2064, 3088, 1024, 512, (bf16_t*)(ws + OFF_W0N) + (size_t)1536 * 1024)
    SEG(p.ab_w_in + 512,  3088, 1024, 512, (bf16_t*)(ws + OFF_W0T) + (size_t)0 * 1024)
    SEG(p.ab_w_in + 2576, 3088, 1024, 512, (bf16_t*)(ws + OFF_W0T) + (size_t)512 * 1024)
    SEG(p.ab_w_out, 1024, 1024, 1024, (bf16_t*)(ws + OFF_WO0))
    SEG(p.ffn_up, 5632, 1024, 5632, (bf16_t*)(ws + OFF_WUP0))
    SEG(p.ffn_up + (size_t)1024 * 5632, 5632, 1024, 5632, (bf16_t*)(ws + OFF_WUP1))
    SEG(p.ffn_down, 1024, 2816, 1024, (bf16_t*)(ws + OFF_WDN0))
    SEG(p.ffn_down + (size_t)2816 * 1024, 1024, 2816, 1024, (bf16_t*)(ws + OFF_WDN1))
    SEG(p.ret_w_in + 0,    6144, 1024, 1024, (bf16_t*)(ws + OFF_W1N) + (size_t)0 * 1024)
    SEG(p.ret_w_in + 3072, 6144, 1024, 1024, (bf16_t*)(ws + OFF_W1N) + (size_t)1024 * 1024)
    SEG(p.ret_w_in + 4096, 6144, 1024, 2048, (bf16_t*)(ws + OFF_W1N) + (size_t)2048 * 1024)
    SEG(p.ret_w_in + 1024, 6144, 1024, 2048, (bf16_t*)(ws + OFF_W1T))
    SEG(p.ret_w_out, 1024, 2048, 1024, (bf16_t*)(ws + OFF_WO1))
#undef SEG
    { bf16_t* SW = (bf16_t*)(ws + OFF_SGUW);
      for (int idx = blockIdx.x * 512 + tid; idx < 4 * 128 * 128; idx += G * 512) SW[idx] = (bf16_t)f2bf(p.ab_sgu_w[idx]); }
}


__device__ __forceinline__ void scan_seq(const P& p, int sq, int lane) {
    const float* GT = (const float*)(p.ws + OFF_GATES);
    float* ROWT = (float*)(p.ws + OFF_ROWT); float* COLT = (float*)(p.ws + OFF_COLT); float* ENM = (float*)(p.ws + OFF_ENM);
    const int bl = sq >> 3, h = (sq >> 1) & 3, dir = sq & 1;
    const int gi = (2 * dir) * 4 + h, gf = (2 * dir + 1) * 4 + h;
    const size_t rb = (size_t)bl * LT;
#define JMAP(pp) (dir == 0 ? (pp) : ((pp) < 256 ? 255 - (pp) : 2559 - (pp)))
    float tot = 0.f;
#pragma unroll 6
    for (int e = 0; e < 36; ++e) { const int pp = lane * 36 + e; const int j = JMAP(pp); tot += logsig(GT[(rb + j) * 16 + gf]); }
    float inc = tot;
#pragma unroll
    for (int o = 1; o < 64; o <<= 1) { const float t = shfl_up_l(inc, o, lane); if (lane >= o) inc += t; }
    const float excl = inc - tot;
    float B = excl, mx = -INFINITY;
#pragma unroll 6
    for (int e = 0; e < 36; ++e) { const int pp = lane * 36 + e; const int j = JMAP(pp); B += logsig(GT[(rb + j) * 16 + gf]); mx = fmaxf(mx, GT[(rb + j) * 16 + gi] - B); }
    float incm = mx;
#pragma unroll
    for (int o = 1; o < 64; o <<= 1) { const float t = shfl_up_l(incm, o, lane); if (lane >= o) incm = fmaxf(incm, t); }
    float cm = shfl_up_l(incm, 1, lane); if (lane == 0) cm = -INFINITY;
    B = excl;
#pragma unroll 6
    for (int e = 0; e < 36; ++e) { const int pp = lane * 36 + e; const int j = JMAP(pp);
        B += logsig(GT[(rb + j) * 16 + gf]); const float a = GT[(rb + j) * 16 + gi] - B; cm = fmaxf(cm, a);
        const size_t oi = (size_t)sq * LT + j;
        ROWT[oi] = -cm * LOG2E; COLT[oi] = a * LOG2E; ENM[oi] = fast_exp2(-(B + cm) * LOG2E); }
#undef JMAP
}
__device__ __forceinline__ void conv_row(const P& p, int r, int lane) {
    const bf16_t* PN = (const bf16_t*)(p.ws + OFF_PN);
    const int j = r % LT; const bool hasp = (j != 0 && j != 256), hasn = (j != 255 && j != 2303);
    const int c0 = lane * 8;
#pragma unroll
    for (int which = 0; which < 2; ++which) {
        const int so = which == 0 ? 512 : 0, wo = which == 0 ? 0 : 512;
        bf16_t* dst = (bf16_t*)(p.ws + (which == 0 ? OFF_QC : OFF_KC));
        const float scale = which == 0 ? 1.0f : 0.08838834764831845f;
        float cur[8], prv[8], nxt[8];
        unpack8(*(const u32x4*)(PN + (size_t)r * 2048 + so + c0), cur);
        if (hasp) unpack8(*(const u32x4*)(PN + (size_t)(r - 1) * 2048 + so + c0), prv); else { for (int i = 0; i < 8; ++i) prv[i] = 0.f; }
        if (hasn) unpack8(*(const u32x4*)(PN + (size_t)(r + 1) * 2048 + so + c0), nxt); else { for (int i = 0; i < 8; ++i) nxt[i] = 0.f; }
        float o[8];
#pragma unroll
        for (int i = 0; i < 8; ++i) {
            const float w0 = p.ab_qk_conv[0 * 1024 + wo + c0 + i], w1 = p.ab_qk_conv[1 * 1024 + wo + c0 + i], w2 = p.ab_qk_conv[2 * 1024 + wo + c0 + i];
            o[i] = silu_f(w0 * prv[i] + w1 * cur[i] + w2 * nxt[i]) * scale;
        }
        u32x4 w; w.x = pk2(o[0], o[1]); w.y = pk2(o[2], o[3]); w.z = pk2(o[4], o[5]); w.w = pk2(o[6], o[7]);
        __builtin_nontemporal_store(w, (u32x4*)(dst + (size_t)r * 512 + c0));
    }
}
__device__ __forceinline__ void conv_rows4(const P& p, int r, int lane) {
    const bf16_t* PN = (const bf16_t*)(p.ws + OFF_PN);
    const int j = r % LT; const bool hasp = (j != 0 && j != 256), hasn = (j + 3 != 255 && j + 3 != 2303);
    const int c0 = lane * 8;
#pragma unroll
    for (int which = 0; which < 2; ++which) {
        const int so = which == 0 ? 512 : 0, wo = which == 0 ? 0 : 512;
        bf16_t* dst = (bf16_t*)(p.ws + (which == 0 ? OFF_QC : OFF_KC));
        const float scale = which == 0 ? 1.0f : 0.08838834764831845f;
        float x[6][8];
#pragma unroll
        for (int k = 0; k < 6; ++k) {
            const bool valid = k == 0 ? hasp : (k == 5 ? hasn : true);
            u32x4 v = (u32x4){0u, 0u, 0u, 0u};
            if (valid) v = *(const u32x4*)(PN + (size_t)(r - 1 + k) * 2048 + so + c0);
            unpack8(v, x[k]);
        }
        float w0[8], w1[8], w2[8];
#pragma unroll
        for (int hq = 0; hq < 2; ++hq) {
            const f32x4 a0 = *(const f32x4*)(p.ab_qk_conv + 0 * 1024 + wo + c0 + 4 * hq), a1 = *(const f32x4*)(p.ab_qk_conv + 1 * 1024 + wo + c0 + 4 * hq), a2 = *(const f32x4*)(p.ab_qk_conv + 2 * 1024 + wo + c0 + 4 * hq);
#pragma unroll
            for (int e = 0; e < 4; ++e) { w0[4 * hq + e] = a0[e]; w1[4 * hq + e] = a1[e]; w2[4 * hq + e] = a2[e]; }
        }
#pragma unroll
        for (int o4 = 0; o4 < 4; ++o4) {
            float o[8];
#pragma unroll
            for (int i = 0; i < 8; ++i) o[i] = silu_f(w0[i] * x[o4][i] + w1[i] * x[o4 + 1][i] + w2[i] * x[o4 + 2][i]) * scale;
            u32x4 w; w.x = pk2(o[0], o[1]); w.y = pk2(o[2], o[3]); w.z = pk2(o[4], o[5]); w.w = pk2(o[6], o[7]);
            __builtin_nontemporal_store(w, (u32x4*)(dst + (size_t)(r + o4) * 512 + c0));
        }
    }
}
__device__ __forceinline__ void valn_block(const P& p, LAS unsigned char* lds, int item, const int tid) {
    const int wave = __builtin_amdgcn_readfirstlane(tid >> 6), lane = tid & 63, rs = lane >> 4, tc = lane & 15;
    char* base = (char*)((bf16_t*)(p.ws + OFF_VT0) + (size_t)(512 + wave * 64) * TG + (size_t)item * 128) + ((unsigned)rs * (unsigned)(TG * 2) + (unsigned)tc * 16u);
    LAS float* R = (LAS float*)lds;
    u32x4 val[16];
    float s[8], q[8];
#pragma unroll
    for (int e = 0; e < 8; ++e) { s[e] = 0.f; q[e] = 0.f; }
#pragma unroll
    for (int it = 0; it < 16; ++it) {
        val[it] = *(const u32x4*)(base + (size_t)it * 4 * TG * 2);
        float f[8]; unpack8(val[it], f);
#pragma unroll
        for (int e = 0; e < 8; ++e) { s[e] += f[e]; q[e] += f[e] * f[e]; }
    }
#pragma unroll
    for (int e = 0; e < 8; ++e) { s[e] += shfl_xor_l(s[e], 16, lane); s[e] += shfl_xor_l(s[e], 32, lane); q[e] += shfl_xor_l(q[e], 16, lane); q[e] += shfl_xor_l(q[e], 32, lane); }
    __syncthreads();
    if (rs == 0) {
        LAS f32x4* dst = (LAS f32x4*)(R + (wave * 16 + tc) * 16);
        dst[0] = (f32x4){s[0], s[1], s[2], s[3]}; dst[1] = (f32x4){s[4], s[5], s[6], s[7]}; dst[2] = (f32x4){q[0], q[1], q[2], q[3]}; dst[3] = (f32x4){q[4], q[5], q[6], q[7]};
    }
    __syncthreads();
#pragma unroll
    for (int e = 0; e < 8; ++e) { s[e] = 0.f; q[e] = 0.f; }
#pragma unroll
    for (int w8 = 0; w8 < 8; ++w8) {
        const LAS f32x4* src = (const LAS f32x4*)(R + (w8 * 16 + tc) * 16);
        const f32x4 a0 = src[0], a1 = src[1], b0 = src[2], b1 = src[3];
        s[0] += a0[0]; s[1] += a0[1]; s[2] += a0[2]; s[3] += a0[3]; s[4] += a1[0]; s[5] += a1[1]; s[6] += a1[2]; s[7] += a1[3];
        q[0] += b0[0]; q[1] += b0[1]; q[2] += b0[2]; q[3] += b0[3]; q[4] += b1[0]; q[5] += b1[1]; q[6] += b1[2]; q[7] += b1[3];
    }
    float mean[8], rstd[8];
#pragma unroll
    for (int e = 0; e < 8; ++e) { mean[e] = s[e] * (1.0f / 512.0f); rstd[e] = rsqrtf(fmaxf(q[e] * (1.0f / 512.0f) - mean[e] * mean[e], 0.f) + 1e-6f); }
#pragma unroll
    for (int it = 0; it < 16; ++it) {
        float f[8]; unpack8(val[it], f);
        u32x4 w; w.x = pk2((f[0] - mean[0]) * rstd[0], (f[1] - mean[1]) * rstd[1]); w.y = pk2((f[2] - mean[2]) * rstd[2], (f[3] - mean[3]) * rstd[3]);
        w.z = pk2((f[4] - mean[4]) * rstd[4], (f[5] - mean[5]) * rstd[5]); w.w = pk2((f[6] - mean[6]) * rstd[6], (f[7] - mean[7]) * rstd[7]);
        *(u32x4*)(base + (size_t)it * 4 * TG * 2) = w;
    }
}

__device__ __forceinline__ void convglu(const P& p, int layer, bool combined, const int tid) {
    const bf16_t* AG = (const bf16_t*)(p.ws + OFF_AG); bf16_t* ACT = (bf16_t*)(p.ws + OFF_ACT);
    const float* WC = p.ffn_conv + (size_t)layer * 9 * DFF;
    const int G8 = gridDim.x >> 3, xcd = blockIdx.x & 7, bix = blockIdx.x >> 3;
    const int rows_per_b = combined ? LT : SEQ, lat0 = combined ? 256 : 0;
    constexpr int BPX = NB / 8;
    const int nlat = BPX * 32 * 8 * 352;
    for (int idx = bix * 512 + tid; idx < nlat; idx += G8 * 512) {
        const int cgl = idx & 31, cb = (idx >> 5) & 7, gr = (idx >> 8) & 31, rest = idx >> 13, cgp = (rest % 11) * 32 + cgl, bl = xcd * BPX + rest / 11;
        const int c = cgp * 8;
        const size_t row0 = (size_t)bl * rows_per_b + lat0 + gr * 64 + cb * 8;
        float acc[8][8];
#pragma unroll
        for (int o = 0; o < 8; ++o)
#pragma unroll
            for (int i = 0; i < 8; ++i) acc[o][i] = 0.f;
#pragma unroll
        for (int dr = 0; dr < 3; ++dr) {
            const int rr = gr + dr - 1;
            if (rr < 0 || rr >= 32) continue;
            u32x4 win[10];
#pragma unroll
            for (int dc = 0; dc < 10; ++dc) {
                const int cc = cb * 8 + dc - 1;
                win[dc] = (u32x4){0u, 0u, 0u, 0u};
                if (cc >= 0 && cc < 64) win[dc] = *(const u32x4*)(AG + (row0 + (long)(dr - 1) * 64 + (dc - 1)) * 5632 + DFF + c);
            }
            float wt[3][8];
#pragma unroll
            for (int t3 = 0; t3 < 3; ++t3) { const f32x4 w0 = *(const f32x4*)(WC + (dr * 3 + t3) * DFF + c), w1 = *(const f32x4*)(WC + (dr * 3 + t3) * DFF + c + 4);
                wt[t3][0] = w0[0]; wt[t3][1] = w0[1]; wt[t3][2] = w0[2]; wt[t3][3] = w0[3]; wt[t3][4] = w1[0]; wt[t3][5] = w1[1]; wt[t3][6] = w1[2]; wt[t3][7] = w1[3]; }
#pragma unroll
            for (int dc = 0; dc < 10; ++dc) {
                float gv[8]; unpack8(win[dc], gv);
#pragma unroll
                for (int o = 0; o < 8; ++o) { const int t3 = dc - o;
                    if (t3 >= 0 && t3 < 3) {
#pragma unroll
                        for (int i = 0; i < 8; ++i) acc[o][i] += gv[i] * wt[t3][i]; } }
            }
        }
#pragma unroll
        for (int o = 0; o < 8; ++o) {
            float av[8]; unpack8(__builtin_nontemporal_load((const u32x4*)(AG + (row0 + o) * 5632 + c)), av);
            u32x4 w; w.x = pk2(gelu_f(acc[o][0]) * av[0], gelu_f(acc[o][1]) * av[1]); w.y = pk2(gelu_f(acc[o][2]) * av[2], gelu_f(acc[o][3]) * av[3]);
            w.z = pk2(gelu_f(acc[o][4]) * av[4], gelu_f(acc[o][5]) * av[5]); w.w = pk2(gelu_f(acc[o][6]) * av[6], gelu_f(acc[o][7]) * av[7]);
            __builtin_nontemporal_store(w, (u32x4*)(ACT + (row0 + o) * DFF + c));
        }
    }
    if (combined) {
        const int nctx = BPX * 256 * 352;
        for (int idx = bix * 512 + tid; idx < nctx; idx += G8 * 512) {
            const int cgp = idx % 352, rest = idx / 352, j = rest & 255, bl = xcd * BPX + (rest >> 8);
            const int c = cgp * 8;
            const size_t row = (size_t)bl * LT + j;
            float acc[8];
#pragma unroll
            for (int i = 0; i < 8; ++i) acc[i] = 0.f;
#pragma unroll
            for (int dc = 0; dc < 3; ++dc) {
                const int jj = j + dc - 1;
                if (jj >= 0 && jj < 256) {
                    float gv[8]; unpack8(*(const u32x4*)(AG + (row + dc - 1) * 5632 + DFF + c), gv);
                    const f32x4 w0 = *(const f32x4*)(WC + (3 + dc) * DFF + c), w1 = *(const f32x4*)(WC + (3 + dc) * DFF + c + 4);
                    acc[0] += gv[0] * w0[0]; acc[1] += gv[1] * w0[1]; acc[2] += gv[2] * w0[2]; acc[3] += gv[3] * w0[3];
                    acc[4] += gv[4] * w1[0]; acc[5] += gv[5] * w1[1]; acc[6] += gv[6] * w1[2]; acc[7] += gv[7] * w1[3];
                }
            }
            float av[8]; unpack8(*(const u32x4*)(AG + row * 5632 + c), av);
            u32x4 w; w.x = pk2(gelu_f(acc[0]) * av[0], gelu_f(acc[1]) * av[1]); w.y = pk2(gelu_f(acc[2]) * av[2], gelu_f(acc[3]) * av[3]);
            w.z = pk2(gelu_f(acc[4]) * av[4], gelu_f(acc[5]) * av[5]); w.w = pk2(gelu_f(acc[6]) * av[6], gelu_f(acc[7]) * av[7]);
            *(u32x4*)(ACT + row * DFF + c) = w;
        }
    }
}

#define XB_TMO      128
#define XB_XCNT(j)  (256  + 64 * (j))
#define XB_XSUB(j)  (1280 + 64 * (j))
#define XB_XGEN(j)  (2304 + 64 * (j))
#define XB_TOP      3328
#define XB_TOPGEN   3392
#define XCD_BAR_WORDS 3456
#define XB_SPIN_CAP (1u << 22)
__device__ __forceinline__ unsigned xb_ld(unsigned* p)              { return __hip_atomic_load(p, __ATOMIC_RELAXED, __HIP_MEMORY_SCOPE_AGENT); }
__device__ __forceinline__ unsigned xb_add(unsigned* p, unsigned v) { return __hip_atomic_fetch_add(p, v, __ATOMIC_RELAXED, __HIP_MEMORY_SCOPE_AGENT); }
__device__ __forceinline__ unsigned xb_xcc_id() { return (unsigned)__builtin_amdgcn_s_getreg((3 << 11) | 20) & 0xFu; }
#define XB_SPIN(cond, bar) do { unsigned _sp = 0; while (cond) { __builtin_amdgcn_s_sleep(1); \
    if ((++_sp & 255u) == 0u) { if (xb_ld(&(bar)[XB_TMO])) break; if (_sp > XB_SPIN_CAP) { atomicAdd(&(bar)[XB_TMO], 1u); break; } } } } while (0)
struct XcdBarrier { unsigned* bar; unsigned x; volatile LAS unsigned* st; };
__device__ __forceinline__ XcdBarrier xcd_barrier_post(unsigned* bar, volatile LAS unsigned* st, bool leader) {
    XcdBarrier b; b.bar = bar; b.x = xb_xcc_id(); b.st = st;
    if (leader) (void)xb_add(&bar[XB_XCNT(b.x)], 1u);
    return b;
}
__device__ __forceinline__ void xcd_barrier_complete(unsigned* bar, unsigned x, unsigned& nloc, unsigned& nx) {
    const unsigned G = gridDim.x * gridDim.y * gridDim.z;
    unsigned sum, cnt, mine, sp = 0u;
    for (;;) {
        sum = 0u; cnt = 0u; mine = 0u;
#pragma unroll
        for (unsigned j = 0; j < 16; ++j) { const unsigned c = xb_ld(&bar[XB_XCNT(j)]); sum += c; cnt += (c > 0u) ? 1u : 0u; mine = (j == x) ? c : mine; }
        if (sum == G) break;
        __builtin_amdgcn_s_sleep(1);
        if ((++sp & 255u) == 0u) { if (xb_ld(&bar[XB_TMO])) break; if (sp > XB_SPIN_CAP) { atomicAdd(&bar[XB_TMO], 1u); break; } }
    }
    nloc = mine > 0u ? mine : 1u; nx = cnt > 0u ? cnt : 1u;
}
__device__ __forceinline__ void xcd_barrier(const XcdBarrier& b, bool leader) {
    asm volatile("s_waitcnt vmcnt(0)" ::: "memory");
    __syncthreads();
    if (leader) {
        unsigned* bar = b.bar;
        __builtin_amdgcn_s_waitcnt(0);
        unsigned nloc = b.st[0], nx = b.st[1];
        if (nloc == 0u) { xcd_barrier_complete(bar, b.x, nloc, nx); b.st[0] = nloc; b.st[1] = nx; }
        const unsigned old = xb_add(&bar[XB_XSUB(b.x)], 1u);
        const unsigned gen = old / nloc;
        if (old + 1u == (gen + 1u) * nloc) {
            __builtin_amdgcn_fence(__ATOMIC_RELEASE, "agent");
            asm volatile("s_waitcnt vmcnt(0)" ::: "memory");
            const unsigned og = xb_add(&bar[XB_TOP], 1u);
            const unsigned tg = og / nx;
            if (og + 1u == (tg + 1u) * nx) xb_add(&bar[XB_TOPGEN], 1u);
            else XB_SPIN(xb_ld(&bar[XB_TOPGEN]) == tg, bar);
            __builtin_amdgcn_fence(__ATOMIC_ACQUIRE, "agent");
            xb_add(&bar[XB_XGEN(b.x)], 1u);
            asm volatile("s_waitcnt vmcnt(0)" ::: "memory");
        } else {
            XB_SPIN(xb_ld(&bar[XB_XGEN(b.x)]) == gen, bar);
            __builtin_amdgcn_fence(__ATOMIC_ACQUIRE, "agent");
            asm volatile("s_waitcnt vmcnt(0)" ::: "memory");
        }
    }
    __syncthreads();
}

struct Args { const float* in[22]; float* out; unsigned char* ws; int ph_lo, ph_hi; };

__global__ void __launch_bounds__(512, 2) mega(Args a) {
    extern __shared__ __attribute__((aligned(16))) unsigned char shm[];
    LAS unsigned char* lds = (LAS unsigned char*)shm;
    cg::grid_group grid = cg::this_grid();
    typedef const __attribute__((address_space(4))) Args* KArgPtr;
#define LOAD_P() KArgPtr ap = (KArgPtr)__builtin_amdgcn_kernarg_segment_ptr(); asm volatile("" : "+s"(ap)); P p; \
    p.x = ap->in[0]; p.c = ap->in[1]; p.ctx = ap->in[2]; p.c_ctx = ap->in[3]; p.ada_w = ap->in[4]; p.ada_b = ap->in[5]; p.pre_g = ap->in[6]; p.post_g = ap->in[7]; \
    p.ffn_up = ap->in[8]; p.ffn_conv = ap->in[9]; p.ffn_down = ap->in[10]; p.ab_w_in = ap->in[11]; p.ab_qk_conv = ap->in[12]; p.ab_gate_b = ap->in[13]; p.ab_sgu_w = ap->in[14]; \
    p.ab_sgu_b = ap->in[15]; p.ab_head_g = ap->in[16]; p.ab_w_out = ap->in[17]; p.ret_w_in = ap->in[18]; p.ret_decay = ap->in[19]; p.ret_head_g = ap->in[20]; p.ret_w_out = ap->in[21]; \
    p.out = ap->out; p.ws = ap->ws;
    const int G = gridDim.x, NGW = G * 8;
    const int lo = a.ph_lo, hi = a.ph_hi;
    int pc = 0;
    const bool fused = (hi - lo) > 1;
    const int wave0 = __builtin_amdgcn_readfirstlane((int)threadIdx.x >> 6);
#define LANE_ID() ([]() __attribute__((always_inline)) { int l_; asm volatile("v_mbcnt_lo_u32_b32 %0, -1, 0\n\tv_mbcnt_hi_u32_b32 %0, -1, %0" : "=v"(l_)); return l_; }())
#define IS_LEADER() (wave0 == 0 && LANE_ID() == 0)
    volatile LAS unsigned* xst = (volatile LAS unsigned*)(lds + LDS_BYTES - 64);
    if (IS_LEADER()) { xst[0] = 0u; xst[1] = 0u; }
    __syncthreads();
    XcdBarrier xb; xb.bar = (unsigned*)(a.ws + OFF_BAR); xb.x = 0; xb.st = xst;
    if (fused) xb = xcd_barrier_post((unsigned*)(a.ws + OFF_BAR), xst, IS_LEADER());
#ifndef ONLY_PHASE
#define ONLY_PHASE -1
#endif
#ifndef DUP_MASK
#define DUP_MASK 0
#endif
#define PH_BEGIN(k) if ((ONLY_PHASE < 0 || ONLY_PHASE == (k)) && pc >= lo && pc < hi) for (int rep_ = 0; rep_ <= ((DUP_MASK >> (k)) & 1); ++rep_) { \
    if (DUP_MASK) __syncthreads(); \
    LOAD_P(); int tid = wave0 * 64 + LANE_ID(); asm volatile("" : "+v"(tid)); unsigned char* ws = p.ws; \
    const int wave = __builtin_amdgcn_readfirstlane(tid >> 6), lane = tid & 63, gw = blockIdx.x * 8 + wave; (void)lane; (void)gw; \
    const float* MOD = (const float*)(ws + OFF_MOD); bf16_t* H = (bf16_t*)(ws + OFF_H); bf16_t* Y = (bf16_t*)(ws + OFF_Y); float* CTXR = (float*)(ws + OFF_CTXR); \
    (void)MOD; (void)H; (void)Y; (void)CTXR;
#define PH_END } ++pc; if (pc > lo && pc < hi) { if (pc == lo + 1) grid.sync(); else xcd_barrier(xb, IS_LEADER()); }


    PH_BEGIN(0) prologue(p, lds, tid); PH_END

#pragma unroll 1
    for (int g = 0; g < NGRP; ++g) {
        const int b0 = g * NB;
        PH_BEGIN(1)
        __syncthreads();
        for (int idx = tid; idx < 16 * 1024; idx += 512) { const int gq = idx >> 10, k = idx & 1023; ((LAS float*)lds)[idx] = p.ab_w_in[(size_t)k * 3088 + 1024 + gq]; }
        __syncthreads();
        for (int r0 = gw * 2; r0 < TG; r0 += NGW * 2)
        { const int rr = 0; const int r = r0 + rr; const int bl = r / LT, j = r % LT, b = b0 + bl;
            const float* xs = j < 256 ? p.ctx + ((size_t)b * 256 + j) * 1024 : p.x + ((size_t)b * SEQ + (j - 256)) * 1024;
            const float* m = MOD + (size_t)(0 * 33 + (j < 256 ? 32 : b)) * 6144;
            row_pass2<true>(xs, nullptr, nullptr, H + (size_t)r * 1024, nullptr, nullptr, p.pre_g + 0 * 1024, m, m + 1024, lane, (const LAS float*)lds, p.ab_gate_b, (float*)(ws + OFF_GATES) + (size_t)r * 16); }
        PH_END
        PH_BEGIN(2)
        { pg8::Sched<pg8::G_L0IN> S; S.ws = ws; S.G = G; S.c = blockIdx.x; pg8::gemm_phase<pg8::G_L0IN>(lds, S, tid); }
        PH_END
        PH_BEGIN(3)
        for (int it = blockIdx.x; it < TG / 128; it += G) valn_block(p, lds, it, tid);
        for (int sq = gw; sq < NB * 8; sq += NGW) scan_seq(p, sq, lane);
        for (int r = gw * 4; r < TG; r += NGW * 4) conv_rows4(p, r, lane);
        PH_END
        PH_BEGIN(4)
        constexpr int N_ML = NB * 4 * 2, N_SGU = NB * 18 * 4;
        if (G >= 2 * N_ML) {
            if ((int)blockIdx.x < N_ML) { const int it = blockIdx.x; mlstm_chunk_item(p, lds, it >> 3, (it >> 1) & 3, it & 1, tid); }
            else for (int i3 = blockIdx.x - N_ML; i3 < N_SGU; i3 += G - N_ML) { const int bl = i3 / 72, rem = i3 % 72; sgu_item(p, bl, rem >> 2, rem & 3, tid); }
        } else
        for (int it = blockIdx.x; it < N_ML + N_SGU; it += G) {
            if (it < N_ML) mlstm_chunk_item(p, lds, it >> 3, (it >> 1) & 3, it & 1, tid);
            else { const int i3 = it - N_ML; const int bl = i3 / 72, rem = i3 % 72; sgu_item(p, bl, rem >> 2, rem & 3, tid); }
        }
        PH_END
        PH_BEGIN(20)
        for (int r = gw * 2; r < TG; r += NGW * 2) mlstm_post_row(p, r, lane);
        PH_END
        PH_BEGIN(5)
        { pg8::Sched<pg8::G_OUT0> S; S.ws = ws; S.G = G; S.c = blockIdx.x; pg8::gemm_phase<pg8::G_OUT0>(lds, S, tid); }
        PH_END
        PH_BEGIN(6)
        for (int r0 = gw * 2; r0 < TG; r0 += NGW * 2)
        { const int rr = 0; const int r = r0 + rr; const int bl = r / LT, j = r % LT, b = b0 + bl;
            const float* xs = j < 256 ? p.ctx + ((size_t)b * 256 + j) * 1024 : p.x + ((size_t)b * SEQ + (j - 256)) * 1024;
            float* xd = j < 256 ? CTXR + ((size_t)bl * 256 + j) * 1024 : p.out + ((size_t)b * SEQ + (j - 256)) * 1024;
            const float* m = MOD + (size_t)(0 * 33 + (j < 256 ? 32 : b)) * 6144;
            row_pass2<false>(xs, Y + (size_t)r * 1024, xd, H + (size_t)r * 1024, p.post_g + 0 * 1024, m + 2 * 1024, p.pre_g + 1 * 1024, m + 3 * 1024, m + 4 * 1024, lane); }
        PH_END
        PH_BEGIN(7)
        { pg8::Sched<pg8::G_UP0> S; S.ws = ws; S.G = G; S.c = blockIdx.x; pg8::gemm_phase<pg8::G_UP0>(lds, S, tid); }
        PH_END
        PH_BEGIN(8) convglu(p, 0, true, tid); PH_END
        PH_BEGIN(9)
        { pg8::Sched<pg8::G_DN0> S; S.ws = ws; S.G = G; S.c = blockIdx.x; pg8::gemm_phase<pg8::G_DN0>(lds, S, tid); }
        PH_END
        PH_BEGIN(10)
        constexpr int NCB = (TG - TL) / 256 * 4;
        if (G >= 2 * NCB && (int)blockIdx.x < NCB) {
            pg8::Sched<pg8::G_DN0C> S; S.ws = ws; S.G = NCB; S.c = blockIdx.x; pg8::gemm_phase<pg8::G_DN0C>(lds, S, tid);
        } else {
            const bool split = G >= 2 * NCB;
            if (!split) { pg8::Sched<pg8::G_DN0C> S; S.ws = ws; S.G = G; S.c = blockIdx.x; pg8::gemm_phase<pg8::G_DN0C>(lds, S, tid); }
            const int gw2 = split ? ((int)blockIdx.x - NCB) * 8 + wave : gw, ngw2 = split ? (G - NCB) * 8 : NGW;
            for (int r0 = gw2 * 2; r0 < TL; r0 += ngw2 * 2)
            { const int rr = 0; const int rl = r0 + rr; const int bl = rl / SEQ, t = rl % SEQ, b = b0 + bl; const size_t r = (size_t)bl * LT + 256 + t;
                float* xd = p.out + ((size_t)b * SEQ + t) * 1024;
                const float* m0 = MOD + (size_t)(0 * 33 + b) * 6144;
                const float* m1 = MOD + (size_t)(1 * 33 + b) * 6144;
                row_pass2<false>(xd, Y + r * 1024, xd, H + r * 1024, p.post_g + 1 * 1024, m0 + 5 * 1024, p.pre_g + 2 * 1024, m1, m1 + 1024, lane); }
        }
        PH_END
        PH_BEGIN(21)
        for (int r0 = gw * 2; r0 < NB * 256; r0 += NGW * 2)
        { const int rr = 0; const int rc = r0 + rr; const int bl = rc >> 8, j = rc & 255; const size_t r = (size_t)bl * LT + j;
            float* xd = CTXR + ((size_t)bl * 256 + j) * 1024;
            const float* m0 = MOD + (size_t)(0 * 33 + 32) * 6144;
            const float* m1 = MOD + (size_t)(1 * 33 + 32) * 6144;
            row_pass2<false>(xd, Y + r * 1024, xd, H + r * 1024, p.post_g + 1 * 1024, m0 + 5 * 1024, p.pre_g + 2 * 1024, m1, m1 + 1024, lane); }
        PH_END
        PH_BEGIN(11)
        { pg8::Sched<pg8::G_L1IN> S; S.ws = ws; S.G = G; S.c = blockIdx.x; pg8::gemm_phase<pg8::G_L1IN>(lds, S, tid); }
        { pg8::Sched<pg8::G_L1B> S; S.ws = ws; S.G = G; S.c = blockIdx.x; pg8::gemm_phase<pg8::G_L1B>(lds, S, tid); }
        PH_END
        PH_BEGIN(12)
        for (int it0 = blockIdx.x; it0 < NB * 4 * 4; it0 += G) {
            const int it = (G == 256) ? (((it0 & 7) * 8 + ((it0 >> 3) >> 2)) * 4 + ((it0 >> 3) & 3)) : it0;
            const int bl = it / 16, rem = it % 16; ret_chunk_item(p, lds, bl, rem >> 2, rem & 3, tid); }
        PH_END
        PH_BEGIN(19)
        for (int r = gw * 2; r < TL; r += NGW * 2) { ret_post_row(p, r, lane); ret_post_row(p, r + 1, lane); }
        PH_END
        PH_BEGIN(13)
        { pg8::Sched<pg8::G_OUT1> S; S.ws = ws; S.G = G; S.c = blockIdx.x; pg8::gemm_phase<pg8::G_OUT1>(lds, S, tid); }
        PH_END
        PH_BEGIN(14)
        for (int r0 = gw * 2; r0 < TL; r0 += NGW * 2)
        { const int rr = 0; const int r = r0 + rr; const int bl = r / SEQ, t = r % SEQ, b = b0 + bl;
            float* xd = p.out + ((size_t)b * SEQ + t) * 1024;
            const float* m1 = MOD + (size_t)(1 * 33 + b) * 6144;
            row_pass2<false>(xd, Y + (size_t)r * 1024, xd, H + (size_t)r * 1024, p.post_g + 2 * 1024, m1 + 2 * 1024, p.pre_g + 3 * 1024, m1 + 3 * 1024, m1 + 4 * 1024, lane); }
        PH_END
        PH_BEGIN(15)
        { pg8::Sched<pg8::G_UP1> S; S.ws = ws; S.G = G; S.c = blockIdx.x; pg8::gemm_phase<pg8::G_UP1>(lds, S, tid); }
        PH_END
        PH_BEGIN(16) convglu(p, 1, false, tid); PH_END
        PH_BEGIN(17)
        { pg8::Sched<pg8::G_DN1> S; S.ws = ws; S.G = G; S.c = blockIdx.x; pg8::gemm_phase<pg8::G_DN1>(lds, S, tid); }
        PH_END
        PH_BEGIN(18)
        for (int r0 = gw * 2; r0 < TL; r0 += NGW * 2)
        { const int rr = 0; const int r = r0 + rr; const int bl = r / SEQ, t = r % SEQ, b = b0 + bl;
            float* xd = p.out + ((size_t)b * SEQ + t) * 1024;
            const float* m1 = MOD + (size_t)(1 * 33 + b) * 6144;
            row_pass2<false>(xd, Y + (size_t)r * 1024, xd, nullptr, p.post_g + 3 * 1024, m1 + 5 * 1024, nullptr, nullptr, nullptr, lane); }
        PH_END
    }
#undef PH_BEGIN
#undef PH_END
}

extern "C" void kernel_launch(void* const* d_in, const int* in_sizes, int n_in, void* d_out, int out_size, void* d_ws, size_t ws_size, hipStream_t stream) {
    static int grid = 0;
    if (grid == 0) {
        if (n_in != 22 || ws_size < WS_END) { fprintf(stderr, "kernel_launch: need 22 inputs and %zu bytes of workspace; got %d, %zu\n", (size_t)WS_END, n_in, ws_size); grid = -1; return; }
        int dev = 0, cus = 0, per_cu = 0;
        hipGetDevice(&dev);
        hipDeviceGetAttribute(&cus, hipDeviceAttributeMultiprocessorCount, dev);
        if (hipFuncSetAttribute((const void*)mega, hipFuncAttributeMaxDynamicSharedMemorySize, LDS_BYTES) != hipSuccess) { fprintf(stderr, "kernel_launch: hipFuncSetAttribute failed\n"); grid = -1; return; }
        if (hipOccupancyMaxActiveBlocksPerMultiprocessor(&per_cu, (const void*)mega, 512, LDS_BYTES) != hipSuccess || per_cu < 1) { fprintf(stderr, "kernel_launch: occupancy query says %d\n", per_cu); per_cu = 1; }
        (void)hipGetLastError();
        grid = cus * per_cu;
        if (grid <= 0) grid = 256;
    }
    if (grid < 0) return;
    Args a{};
    for (int i = 0; i < 22; ++i) a.in[i] = (const float*)d_in[i];
    a.out = (float*)d_out; a.ws = (unsigned char*)d_ws;
#if MK_MULTI
    for (int ph = 0; ph < NPHASE; ++ph) {
        a.ph_lo = ph; a.ph_hi = ph + 1;
        hipLaunchKernelGGL(mega, dim3(grid), dim3(512), LDS_BYTES, stream, a);
    }
#else
    a.ph_lo = 0; a.ph_hi = NPHASE;
    if (hipMemsetAsync((char*)d_ws + OFF_BAR, 0, (size_t)XCD_BAR_WORDS_C * 4, stream) != hipSuccess) { fprintf(stderr, "kernel_launch: memset failed\n"); return; }
    void* args[] = {&a};
    hipError_t e = hipLaunchCooperativeKernel((const void*)mega, dim3(grid), dim3(512), args, LDS_BYTES, stream);
    if (e != hipSuccess) fprintf(stderr, "cooperative launch failed: %s (grid %d)\n", hipGetErrorString(e), grid);
#endif
}
```

```cpp
#include <hip/hip_runtime.h>
#include <hip/hip_cooperative_groups.h>
#include <cstdio>
#include <cstdint>
namespace cg = cooperative_groups;

#ifndef MK_MULTI
#define MK_MULTI 0
#endif

#define LAS __attribute__((address_space(3)))
typedef unsigned short bf16_t;
typedef short bf16x8 __attribute__((ext_vector_type(8)));
typedef float f32x4 __attribute__((ext_vector_type(4)));
typedef unsigned u32x4 __attribute__((ext_vector_type(4)));
typedef unsigned u32x2 __attribute__((ext_vector_type(2)));

constexpr int D = 1024, NBATCH = 32, SEQ = 2048, CTXL = 256, LT = 2304;
constexpr int NB = 16, NGRP = NBATCH / NB;
constexpr int TG = NB * LT;
constexpr int TL = NB * SEQ;
constexpr int DFF = 2816;
constexpr int LDS_BYTES = 147456;
constexpr int NPHASE = 1 + NGRP * 21;
constexpr float LOG2E = 1.4426950408889634f;
constexpr int XCD_BAR_WORDS_C = 3456;

constexpr size_t al256(size_t x) { return (x + 255) & ~(size_t)255; }
constexpr size_t OFF_MOD  = 0;
constexpr size_t OFF_W0N  = al256(OFF_MOD + (size_t)2 * 33 * 6144 * 4);
constexpr size_t OFF_W0T  = OFF_W0N + (size_t)2048 * 1024 * 2;
constexpr size_t OFF_WO0  = OFF_W0T + (size_t)1024 * 1024 * 2;
constexpr size_t OFF_WUP0 = OFF_WO0 + (size_t)1024 * 1024 * 2;
constexpr size_t OFF_WUP1 = OFF_WUP0 + (size_t)5632 * 1024 * 2;
constexpr size_t OFF_WDN0 = OFF_WUP1 + (size_t)5632 * 1024 * 2;
constexpr size_t OFF_WDN1 = OFF_WDN0 + (size_t)1024 * 2816 * 2;
constexpr size_t OFF_W1N  = OFF_WDN1 + (size_t)1024 * 2816 * 2;
constexpr size_t OFF_W1T  = OFF_W1N + (size_t)4096 * 1024 * 2;
constexpr size_t OFF_WO1  = OFF_W1T + (size_t)2048 * 1024 * 2;
constexpr size_t OFF_SGUW = OFF_WO1 + (size_t)1024 * 2048 * 2;
constexpr size_t OFF_ROWT = OFF_SGUW + (size_t)4 * 128 * 128 * 2;
constexpr size_t OFF_COLT = OFF_ROWT + (size_t)NB * 8 * LT * 4;
constexpr size_t OFF_ENM  = OFF_COLT + (size_t)NB * 8 * LT * 4;
constexpr size_t OFF_GATES= OFF_ENM + (size_t)NB * 8 * LT * 4;
constexpr size_t OFF_CTXR = OFF_GATES + (size_t)TG * 16 * 4;
constexpr size_t OFF_H    = OFF_CTXR + (size_t)NB * 256 * 1024 * 4;
constexpr size_t OFF_Y    = OFF_H + (size_t)TG * 1024 * 2;
constexpr size_t OFF_BIG  = OFF_Y + (size_t)TG * 1024 * 2;
constexpr size_t OFF_PN   = OFF_BIG;
constexpr size_t OFF_VT0  = OFF_PN + (size_t)TG * 2048 * 2;
constexpr size_t OFF_QC   = OFF_VT0 + (size_t)1024 * TG * 2;
constexpr size_t OFF_KC   = OFF_QC + (size_t)TG * 512 * 2;
constexpr size_t OFF_RF   = OFF_KC + (size_t)TG * 512 * 2;
constexpr size_t OFF_RB   = OFF_RF + (size_t)TG * 512 * 2;
constexpr size_t OFF_AG   = OFF_BIG;
constexpr size_t OFF_ACT  = OFF_AG + (size_t)TG * 5632 * 2;
constexpr size_t OFF_K1   = OFF_BIG;
constexpr size_t OFF_Q1   = OFF_K1 + (size_t)TG * 1024 * 2;
constexpr size_t OFF_G1   = OFF_Q1 + (size_t)TG * 1024 * 2;
constexpr size_t OFF_VT1  = OFF_G1 + (size_t)TG * 2048 * 2;
constexpr size_t OFF_K1T  = OFF_VT1 + (size_t)2048 * TG * 2;
constexpr size_t OFF_MRG  = OFF_K1T + (size_t)1024 * TG * 2;
constexpr size_t END_FFN  = OFF_ACT + (size_t)TG * 2816 * 2;
constexpr size_t OFF_MRG2 = OFF_MRG + (size_t)TL * 2048 * 2;
constexpr size_t END_MIX1 = OFF_MRG2 + (size_t)TL * 2048 * 2;
constexpr size_t OFF_BAR  = al256(END_FFN > END_MIX1 ? END_FFN : END_MIX1);
constexpr size_t WS_END   = OFF_BAR + (size_t)XCD_BAR_WORDS_C * 4;
static_assert(WS_END <= (size_t)1020 * 1024 * 1024, "workspace budget");
static_assert(OFF_RB + (size_t)TG * 512 * 2 <= END_FFN, "mixer0 region");

__device__ __forceinline__ unsigned f2bf(float f) { unsigned u = __float_as_uint(f); return (u + 0x7fffu + ((u >> 16) & 1u)) >> 16; }
__device__ __forceinline__ unsigned pk2(float lo, float hi) { return f2bf(lo) | (f2bf(hi) << 16); }
__device__ __forceinline__ float bf2f(bf16_t b) { return __uint_as_float(((unsigned)b) << 16); }
__device__ __forceinline__ float bflo(unsigned w) { return __uint_as_float(w << 16); }
__device__ __forceinline__ float bfhi(unsigned w) { return __uint_as_float(w & 0xffff0000u); }
__device__ __forceinline__ unsigned cvt_pk_bf16(float lo, float hi) { unsigned r; asm volatile("v_cvt_pk_bf16_f32 %0, %1, %2" : "=v"(r) : "v"(lo), "v"(hi)); return r; }
__device__ __forceinline__ float fast_exp2(float x) { return __builtin_amdgcn_exp2f(x); }
__device__ __forceinline__ float fast_rcp(float x) { return __builtin_amdgcn_rcpf(x); }
__device__ __forceinline__ float logsig(float x) { return fminf(x, 0.f) - 0.6931471805599453f * __builtin_amdgcn_logf(1.0f + fast_exp2(-fabsf(x) * LOG2E)); }
__device__ __forceinline__ float sigmoid_f(float x) { return fast_rcp(1.0f + fast_exp2(-x * LOG2E)); }
__device__ __forceinline__ float silu_f(float x) { return x * sigmoid_f(x); }
__device__ __forceinline__ float gelu_f(float x) {
    const float u = 0.7978845608028654f * (x + 0.044715f * x * x * x);
    return x * fast_rcp(1.0f + fast_exp2(-2.0f * LOG2E * u));
}
__device__ __forceinline__ float shfl_idx(float v, int src) { return __int_as_float(__builtin_amdgcn_ds_bpermute(src << 2, __float_as_int(v))); }
__device__ __forceinline__ float shfl_xor_l(float v, int m, int lane) { return shfl_idx(v, lane ^ m); }
__device__ __forceinline__ float shfl_up_l(float v, int o, int lane) { return shfl_idx(v, (lane - o) & 63); }
__device__ __forceinline__ float wave_sum(float v, int lane) {
#pragma unroll
    for (int o = 1; o < 64; o <<= 1) v += shfl_xor_l(v, o, lane);
    return v;
}
__device__ __forceinline__ void unpack8(const u32x4 w, float (&f)[8]) {
    f[0] = bflo(w.x); f[1] = bfhi(w.x); f[2] = bflo(w.y); f[3] = bfhi(w.y); f[4] = bflo(w.z); f[5] = bfhi(w.z); f[6] = bflo(w.w); f[7] = bfhi(w.w);
}
#define LDS_WAIT() asm volatile("s_waitcnt lgkmcnt(0)" ::: "memory")

namespace pg8 {
constexpr int BM = 256, BK = 64, HALF = 128, HTB = HALF * BK * 2, STAGE_BYTES = 8 * HTB, NXCD = 8, WGM = 8;
__host__ __device__ __forceinline__ int lds_byte(int r, int c) { const int st = (r >> 4) * 2 + (c >> 5), rr = r & 15, cc = c & 31, ob = rr * 64 + cc * 2; return st * 1024 + (ob ^ (((ob >> 9) & 1) << 5)); }
__host__ __device__ __forceinline__ void stage_rc(int b, int& R, int& C) { const int st = b / 1024, sb = b % 1024, swz = sb ^ (((sb >> 9) & 1) << 5); R = (st >> 1) * 16 + swz / 64; C = (st & 1) * 32 + (swz % 64) / 2; }
__host__ __device__ __forceinline__ int perm32(int rho) { const int n = rho >> 4, i = rho & 15; return 8 * (i >> 2) + 4 * n + (i & 3); }

enum { ACT_NONE = 0, ACT_GELU = 1, ACT_SIGMOID = 2, ACT_SILU = 3, ACT_GATES = 9 };
struct Unit { const char* a; const char* b; bf16_t* o; int ldc; int act; float scale; };

enum { G_L0IN = 0, G_OUT0, G_UP0, G_DN0, G_L1IN, G_OUT1, G_UP1, G_DN1, G_L1B, G_DN0C };
template <int PH> struct Sched {
    unsigned char* ws; int G, c;
    static constexpr int KDIM = (PH == G_DN0 || PH == G_DN1 || PH == G_DN0C) ? DFF : (PH == G_OUT1 ? 2048 : 1024);
    static constexpr size_t tstep = (size_t)256 * KDIM * 2;
    static constexpr int MT = TG / 256, ML = TL / 256;
    static constexpr int N0 = PH == G_L0IN ? MT * 8 : PH == G_OUT0 ? MT * 4 : PH == G_UP0 ? MT * 22 : PH == G_DN0 ? ML * 4 : PH == G_DN0C ? (MT - ML) * 4 : PH == G_L1IN ? MT * 4 : PH == G_OUT1 ? ML * 4 : PH == G_UP1 ? ML * 22 : PH == G_L1B ? ML * 12 : ML * 4;
    static constexpr int N1 = PH == G_L0IN ? 4 * MT : PH == G_L1IN ? 8 * MT : 0;
    static constexpr int N2 = 0;
    static constexpr int N3 = 0;
    static __device__ __forceinline__ void tile(int wgid, int nM, int nN, int& pm, int& pn) {
        const int nwg = nM * nN;
        { const int q = nwg / NXCD, r = nwg % NXCD, xcd = wgid % NXCD, off = wgid / NXCD; wgid = (xcd < r ? xcd * (q + 1) : r * (q + 1) + (xcd - r) * q) + off; }
        const int nig = WGM * nN, gid = wgid / nig, fm = gid * WGM, gsz = (nM - fm) < WGM ? (nM - fm) : WGM;
        pm = fm + ((wgid % nig) % gsz); pn = (wgid % nig) / gsz;
    }
    __device__ __forceinline__ void plain(int L, size_t offA, size_t offB, size_t offO, int nM, int nN, Unit& u) const {
        int pm, pn; tile(L, nM, nN, pm, pn);
        u.a = (const char*)ws + offA + (size_t)pm * tstep; u.b = (const char*)ws + offB + (size_t)pn * tstep;
        u.ldc = nN * 256; u.o = (bf16_t*)(ws + offO) + (size_t)pm * 256 * (nN * 256) + pn * 256;
    }
    __device__ __forceinline__ bool next(int i, Unit& u) const {
        const long LL = (long)i * G + c;
        if (LL >= (long)N0 + N1 + N2 + N3) return false;
        const int L = (int)LL;
        u.scale = 1.0f; u.act = ACT_NONE;
        if constexpr (PH == G_L0IN) {
            if (L < N0) { int pm, pn; tile(L, MT, 8, pm, pn);
                u.a = (const char*)ws + OFF_H + (size_t)pm * tstep; u.b = (const char*)ws + OFF_W0N + (size_t)pn * tstep;
                u.o = (bf16_t*)(ws + OFF_PN) + (size_t)pm * 256 * 2048 + pn * 256; u.ldc = 2048; u.act = pn < 4 ? ACT_NONE : (pn < 6 ? ACT_SIGMOID : ACT_GELU);
            } else { int pm, pn; tile(L - N0, 4, MT, pm, pn);
                u.a = (const char*)ws + OFF_W0T + (size_t)pm * tstep; u.b = (const char*)ws + OFF_H + (size_t)pn * tstep;
                u.o = (bf16_t*)(ws + OFF_VT0) + (size_t)pm * 256 * TG + pn * 256; u.ldc = TG; u.act = pm >= 2 ? ACT_GELU : ACT_NONE; }
        } else if constexpr (PH == G_L1IN) {
            if (L < N0) { int pm, pn; tile(L, MT, 4, pm, pn);
                u.a = (const char*)ws + OFF_H + (size_t)pm * tstep; u.b = (const char*)ws + OFF_W1N + (size_t)pn * tstep;
                u.ldc = 1024; u.o = (bf16_t*)(ws + OFF_K1) + (size_t)pm * 256 * 1024 + pn * 256; u.scale = 0.0625f;
            } else if (L < N0 + N1) { int pm, pn; tile(L - N0, 8, MT, pm, pn);
                u.a = (const char*)ws + OFF_W1T + (size_t)pm * tstep; u.b = (const char*)ws + OFF_H + (size_t)pn * tstep;
                u.o = (bf16_t*)(ws + OFF_VT1) + (size_t)pm * 256 * TG + pn * 256; u.ldc = TG;
            } else { int pm, pn; tile(L - N0 - N1, 4, MT, pm, pn);
                u.a = (const char*)ws + OFF_W1N + (size_t)pm * tstep; u.b = (const char*)ws + OFF_H + (size_t)pn * tstep;
                u.o = (bf16_t*)(ws + OFF_K1T) + (size_t)pm * 256 * TG + pn * 256; u.ldc = TG; u.scale = 0.0625f; }
        } else if constexpr (PH == G_L1B) {
            int pm, pn; tile(L, ML, 12, pm, pn);
            const int cm = (pm >> 3) * 9 + 1 + (pm & 7);
            u.a = (const char*)ws + OFF_H + (size_t)cm * tstep; u.b = (const char*)ws + OFF_W1N + (size_t)(4 + pn) * tstep;
            if (pn < 4) { u.ldc = 1024; u.o = (bf16_t*)(ws + OFF_Q1) + (size_t)cm * 256 * 1024 + pn * 256; }
            else { u.ldc = 2048; u.o = (bf16_t*)(ws + OFF_G1) + (size_t)cm * 256 * 2048 + (pn - 4) * 256; u.act = ACT_SILU; }
        }
        else if constexpr (PH == G_OUT0) plain(L, OFF_H, OFF_WO0, OFF_Y, MT, 4, u);
        else if constexpr (PH == G_UP0) plain(L, OFF_H, OFF_WUP0, OFF_AG, MT, 22, u);
        else if constexpr (PH == G_DN0) {
            int pm, pn; tile(L, ML, 4, pm, pn); const int cm = (pm >> 3) * 9 + 1 + (pm & 7);
            u.a = (const char*)ws + OFF_ACT + (size_t)cm * tstep; u.b = (const char*)ws + OFF_WDN0 + (size_t)pn * tstep;
            u.ldc = 1024; u.o = (bf16_t*)(ws + OFF_Y) + (size_t)cm * 256 * 1024 + pn * 256;
        } else if constexpr (PH == G_DN0C) {
            int pm, pn; tile(L, MT - ML, 4, pm, pn); const int cm = pm * 9;
            u.a = (const char*)ws + OFF_ACT + (size_t)cm * tstep; u.b = (const char*)ws + OFF_WDN0 + (size_t)pn * tstep;
            u.ldc = 1024; u.o = (bf16_t*)(ws + OFF_Y) + (size_t)cm * 256 * 1024 + pn * 256;
        }
        else if constexpr (PH == G_OUT1) plain(L, OFF_MRG, OFF_WO1, OFF_Y, ML, 4, u);
        else if constexpr (PH == G_UP1) plain(L, OFF_H, OFF_WUP1, OFF_AG, ML, 22, u);
        else plain(L, OFF_ACT, OFF_WDN1, OFF_Y, ML, 4, u);
        return true;
    }
};

__device__ __forceinline__ f32x4 act4(f32x4 v, int act, float scale) {
    if (act == ACT_GELU) { v[0] = gelu_f(v[0]); v[1] = gelu_f(v[1]); v[2] = gelu_f(v[2]); v[3] = gelu_f(v[3]); }
    else if (act == ACT_SIGMOID) { v[0] = sigmoid_f(v[0]); v[1] = sigmoid_f(v[1]); v[2] = sigmoid_f(v[2]); v[3] = sigmoid_f(v[3]); }
    else if (act == ACT_SILU) { v[0] = silu_f(v[0]); v[1] = silu_f(v[1]); v[2] = silu_f(v[2]); v[3] = silu_f(v[3]); }
    else v = v * scale;
    return v;
}
__device__ __forceinline__ void epi_store(const f32x4 (&acc)[2][2][4][2], const Unit& u, int wr, int wc, int fr, int fq) {
    const int row0 = wr * 64 + fr, col0 = wc * 32 + 8 * fq;
#pragma unroll
    for (int ai = 0; ai < 2; ++ai)
#pragma unroll
        for (int m = 0; m < 4; ++m) {
            bf16_t* rowp = u.o + (size_t)(row0 + ai * HALF + m * 16) * u.ldc + col0;
#pragma unroll
            for (int bj = 0; bj < 2; ++bj) {
                const f32x4 v0 = act4(acc[ai][bj][m][0], u.act, u.scale), v1 = act4(acc[ai][bj][m][1], u.act, u.scale);
                u32x4 w; w.x = cvt_pk_bf16(v0[0], v0[1]); w.y = cvt_pk_bf16(v0[2], v0[3]); w.z = cvt_pk_bf16(v1[0], v1[1]); w.w = cvt_pk_bf16(v1[2], v1[3]);
                *(u32x4*)(rowp + bj * HALF) = w;
            }
        }
}

template <int PH>
__device__ __forceinline__ void gemm_phase(LAS unsigned char* lds, const Sched<PH>& S, const int tid) {
    int K = Sched<PH>::KDIM; asm volatile("" : "+s"(K));
    const int wid = __builtin_amdgcn_readfirstlane(tid >> 6), lane = tid & 63, wr = wid >> 2, wc = wid & 3, fr = lane & 15, fq = lane >> 4;
    const int nt = K / BK;
    unsigned voffA[2], voffB[2];
#pragma unroll
    for (int i = 0; i < 2; ++i) { int R, C; stage_rc(tid * 16 + i * 8192, R, C); const int Rb = (R & ~31) + perm32(R & 31);
        voffA[i] = (unsigned)(R * K + C) * 2u; voffB[i] = (unsigned)(Rb * K + C) * 2u; }
    const size_t kstep = (size_t)(BK * 2);
    const size_t hstep = (size_t)HALF * K * 2;
    const unsigned ldsw = (unsigned)wid * 1024u;
    const unsigned ldsbase = (unsigned)(size_t)lds;
    const int aoff = lds_byte(wr * 64 + fr, fq * 8), boff = lds_byte(wc * 32 + fr, fq * 8);
#define PG8_SA(b, h) (((b) * 2 + (h)) * HTB)
#define PG8_SB(b, h) ((4 + (b) * 2 + (h)) * HTB)
#define PG8_STAGE(bufoff, gbase, voff) do { _Pragma("unroll") for (int _i = 0; _i < 2; ++_i) { \
        const unsigned _m0 = ldsbase + (unsigned)(bufoff) + ldsw + _i * 8192; const char* _gb = (const char*)(gbase); \
        unsigned _keep; asm volatile("s_mov_b32 %0, m0\n\ts_mov_b32 m0, %1\n\ts_nop 0\n\tglobal_load_lds_dwordx4 %2, %3\n\ts_mov_b32 m0, %0" : "=&s"(_keep) : "s"(_m0), "v"((voff)[_i]), "s"(_gb) : "memory"); } } while (0)
#define PG8_LDA(dst, b, h) do { _Pragma("unroll") for (int m = 0; m < 4; ++m) _Pragma("unroll") for (int k = 0; k < 2; ++k) dst[m][k] = *(const LAS bf16x8*)(lds + PG8_SA(b, h) + aoff + m * 2048 + k * 1024); } while (0)
#define PG8_LDB(dst, b, h) do { _Pragma("unroll") for (int n = 0; n < 2; ++n) _Pragma("unroll") for (int k = 0; k < 2; ++k) dst[n][k] = *(const LAS bf16x8*)(lds + PG8_SB(b, h) + boff + n * 2048 + k * 1024); } while (0)
#define PG8_MMA(ai, bj, At, Bt) do { __builtin_amdgcn_s_setprio(1); _Pragma("unroll") for (int m = 0; m < 4; ++m) _Pragma("unroll") for (int n = 0; n < 2; ++n) _Pragma("unroll") for (int k = 0; k < 2; ++k) \
        acc[ai][bj][m][n] = __builtin_amdgcn_mfma_f32_16x16x32_bf16(Bt[n][k], At[m][k], acc[ai][bj][m][n], 0, 0, 0); __builtin_amdgcn_s_setprio(0); } while (0)
#define PG8_WAIT_V(n) asm volatile("s_waitcnt vmcnt(" #n ")" ::: "memory")
#define PG8_WAIT_L(n) asm volatile("s_waitcnt lgkmcnt(" #n ")" ::: "memory")
#define PG8_BAR __builtin_amdgcn_s_barrier()
#define PG8_SCHED __builtin_amdgcn_sched_barrier(0)
    Unit cur, nxt; int ui = 0;
    if (!S.next(0, cur)) return;
    f32x4 acc[2][2][4][2];
#pragma unroll
    for (int a = 0; a < 2; ++a)
#pragma unroll
        for (int b = 0; b < 2; ++b)
#pragma unroll
            for (int m = 0; m < 4; ++m)
#pragma unroll
                for (int n = 0; n < 2; ++n) acc[a][b][m][n] = (f32x4){0.f, 0.f, 0.f, 0.f};
    bf16x8 At[4][2], B0[2][2], B1[2][2];
    const char* cA = cur.a; const char* cB = cur.b;
    PG8_STAGE(PG8_SB(0, 0), cB, voffB); PG8_STAGE(PG8_SB(0, 1), cB + hstep, voffB); PG8_STAGE(PG8_SA(0, 0), cA, voffA); PG8_STAGE(PG8_SA(0, 1), cA + hstep, voffA);
    if (wr == 1) PG8_BAR;
    PG8_WAIT_V(2); PG8_BAR;
    PG8_STAGE(PG8_SB(1, 0), cB + kstep, voffB); PG8_STAGE(PG8_SA(1, 0), cA + kstep, voffA); PG8_STAGE(PG8_SB(1, 1), cB + hstep + kstep, voffB);
    PG8_WAIT_V(6); PG8_BAR;
    for (;;) {
        const bool has_next = S.next(ui + 1, nxt);
        const char* nA = has_next ? nxt.a : cA; const char* nB = has_next ? nxt.b : cB;
        for (int t = 0; t < nt; t += 2) {
            const bool last = (t == nt - 2);
            const char* a1 = cA + (size_t)(t + 1) * kstep;
            const char* a2 = last ? nA : cA + (size_t)(t + 2) * kstep; const char* b2 = last ? nB : cB + (size_t)(t + 2) * kstep;
            const char* a3 = a2 + kstep; const char* b3 = b2 + kstep;
            PG8_LDB(B0, 0, 0); PG8_LDB(B1, 0, 1); PG8_SCHED; PG8_LDA(At, 0, 0); PG8_STAGE(PG8_SA(1, 1), a1 + hstep, voffA);
            PG8_WAIT_V(8); PG8_WAIT_L(0); PG8_BAR; PG8_MMA(0, 0, At, B0); PG8_MMA(0, 1, At, B1); PG8_BAR; PG8_SCHED;
            PG8_LDA(At, 0, 1); PG8_STAGE(PG8_SB(0, 0), b2, voffB); PG8_STAGE(PG8_SB(0, 1), b2 + hstep, voffB); PG8_STAGE(PG8_SA(0, 0), a2, voffA);
            PG8_WAIT_V(8); PG8_WAIT_L(0); PG8_BAR; PG8_MMA(1, 0, At, B0); PG8_MMA(1, 1, At, B1); PG8_BAR; PG8_SCHED;
            PG8_LDB(B0, 1, 0); PG8_LDB(B1, 1, 1); PG8_SCHED; PG8_LDA(At, 1, 0); PG8_STAGE(PG8_SA(0, 1), a2 + hstep, voffA);
            PG8_WAIT_V(8); PG8_WAIT_L(0); PG8_BAR; PG8_MMA(0, 0, At, B0); PG8_MMA(0, 1, At, B1); PG8_BAR; PG8_SCHED;
            PG8_LDA(At, 1, 1); PG8_STAGE(PG8_SB(1, 0), b3, voffB); PG8_STAGE(PG8_SB(1, 1), b3 + hstep, voffB); PG8_STAGE(PG8_SA(1, 0), a3, voffA);
            PG8_WAIT_V(8); PG8_WAIT_L(0); PG8_BAR; PG8_MMA(1, 0, At, B0); PG8_MMA(1, 1, At, B1); PG8_BAR; PG8_SCHED;
        }
        if (wr == 0) PG8_BAR;
        epi_store(acc, cur, wr, wc, fr, fq);
        if (!has_next) break;
#pragma unroll
        for (int a = 0; a < 2; ++a)
#pragma unroll
            for (int b = 0; b < 2; ++b)
#pragma unroll
                for (int m = 0; m < 4; ++m)
#pragma unroll
                    for (int n = 0; n < 2; ++n) acc[a][b][m][n] = (f32x4){0.f, 0.f, 0.f, 0.f};
        cur = nxt; cA = nA; cB = nB; ++ui;
        if (wr == 1) PG8_BAR;
    }
    PG8_WAIT_V(0);
    PG8_BAR;
#undef PG8_SA
#undef PG8_SB
#undef PG8_STAGE
#undef PG8_LDA
#undef PG8_LDB
#undef PG8_MMA
#undef PG8_WAIT_V
#undef PG8_WAIT_L
#undef PG8_BAR
#undef PG8_SCHED
}
}

struct P {
    const float *x, *c, *ctx, *c_ctx, *ada_w, *ada_b, *pre_g, *post_g, *ffn_up, *ffn_conv, *ffn_down, *ab_w_in, *ab_qk_conv, *ab_gate_b, *ab_sgu_w, *ab_sgu_b,
                *ab_head_g, *ab_w_out, *ret_w_in, *ret_decay, *ret_head_g, *ret_w_out;
    float* out; unsigned char* ws;
};

constexpr int MC_S = 136;
constexpr int MC_OFF_V = 0, MC_OFF_RT = MC_OFF_V + 144 * MC_S * 2, MC_OFF_K = MC_OFF_RT + 144 * MC_S * 2;
static_assert(MC_OFF_K + 128 * MC_S * 2 <= LDS_BYTES - 64, "mlstm chunk LDS");
__device__ __forceinline__ void mlstm_chunk_item(const P& p, LAS unsigned char* lds, int bl, int h, int dir, const int tid0) {
    const int wave = __builtin_amdgcn_readfirstlane(tid0 >> 6);
    const bf16_t* QC = (const bf16_t*)(p.ws + OFF_QC); const bf16_t* KC = (const bf16_t*)(p.ws + OFF_KC); const bf16_t* VT = (const bf16_t*)(p.ws + OFF_VT0);
    bf16_t* RO = (bf16_t*)(p.ws + (dir ? OFF_RB : OFF_RF));
    const float* ROWT = (const float*)(p.ws + OFF_ROWT); const float* COLT = (const float*)(p.ws + OFF_COLT); const float* ENM = (const float*)(p.ws + OFF_ENM);
    LAS bf16_t* Vs = (LAS bf16_t*)(lds + MC_OFF_V); LAS bf16_t* RT = (LAS bf16_t*)(lds + MC_OFF_RT); LAS bf16_t* Ks = (LAS bf16_t*)(lds + MC_OFF_K);
    const size_t rowbase = (size_t)bl * LT;
    const size_t sbase = (size_t)((bl * 4 + h) * 2 + dir) * LT;
    f32x4 st[9];
#pragma unroll
    for (int mt = 0; mt < 9; ++mt) st[mt] = (f32x4){0.f, 0.f, 0.f, 0.f};
    __syncthreads();
    for (int idx = tid0; idx < 15 * MC_S / 2; idx += 512) ((LAS unsigned*)(Vs + 129 * MC_S))[idx] = 0u;
#define MC_J(pp) (dir == 0 ? (pp) : ((pp) < 256 ? 255 - (pp) : 2559 - (pp)))
#define MC_CJ(sx) (dir == 0 ? (sx) : ((sx) < 2 ? 1 - (sx) : 19 - (sx)))
    u32x4 pv[4], pk[4]; f32x4 cz[2]; bf16x8 qf[4];
    {
        int t0 = tid0; asm volatile("" : "+v"(t0)); const int tid = t0, lane = tid & 63, l15 = lane & 15, quad = lane >> 4, vpart = tid & 15;
        const int cj = MC_CJ(0); const size_t tok0 = rowbase + (size_t)cj * 128;
        const char* vbase = (const char*)(VT + (size_t)(h * 128) * TG + tok0);
        const unsigned voff = (unsigned)(tid >> 4) * (unsigned)(TG * 2) + (unsigned)vpart * 16u;
        const char* kbase = (const char*)(KC + tok0 * 512 + h * 128);
        const unsigned koff = (unsigned)(((tid >> 4) * 512 + vpart * 8) * 2);
#pragma unroll
        for (int i = 0; i < 4; ++i) pv[i] = *(const u32x4*)(vbase + (size_t)i * 32 * TG * 2 + voff);
#pragma unroll
        for (int i = 0; i < 4; ++i) pk[i] = *(const u32x4*)(kbase + (size_t)i * 32 * 512 * 2 + koff);
        cz[0] = *(const f32x4*)(COLT + sbase + cj * 128 + vpart * 8); cz[1] = *(const f32x4*)(COLT + sbase + cj * 128 + vpart * 8 + 4);
#pragma unroll
        for (int ks = 0; ks < 4; ++ks) qf[ks] = *(const bf16x8*)((const char*)(QC + tok0 * 512 + h * 128) + (unsigned)(((wave * 16 + l15) * 512 + quad * 8) * 2) + ks * 64);
    }
#pragma unroll 1
    for (int sidx = 0; sidx < 18; ++sidx) {
        const int cj = MC_CJ(sidx);
        const size_t tok0 = rowbase + (size_t)cj * 128;
        int tl = tid0; asm volatile("" : "+v"(tl));
        const int tid = tl, lane = tid & 63, l15 = lane & 15, quad = lane >> 4, vpart = tid & 15;
        const float Rend = ROWT[sbase + MC_J(128 * sidx + 127)];
        const float Rprev = sidx ? ROWT[sbase + MC_J(128 * sidx - 1)] : Rend;
        const int qpos = wave * 16 + l15;
        const float rtq = ROWT[sbase + cj * 128 + qpos];
        const float enq = ENM[sbase + cj * 128 + qpos];
        __syncthreads();
        {
            float zf[8];
            zf[0] = fast_exp2(cz[0][0] + Rend); zf[1] = fast_exp2(cz[0][1] + Rend); zf[2] = fast_exp2(cz[0][2] + Rend); zf[3] = fast_exp2(cz[0][3] + Rend);
            zf[4] = fast_exp2(cz[1][0] + Rend); zf[5] = fast_exp2(cz[1][1] + Rend); zf[6] = fast_exp2(cz[1][2] + Rend); zf[7] = fast_exp2(cz[1][3] + Rend);
#pragma unroll
            for (int i = 0; i < 4; ++i) {
                float f[8]; unpack8(pv[i], f);
                u32x4 w; w.x = pk2(f[0] * zf[0], f[1] * zf[1]); w.y = pk2(f[2] * zf[2], f[3] * zf[3]); w.z = pk2(f[4] * zf[4], f[5] * zf[5]); w.w = pk2(f[6] * zf[6], f[7] * zf[7]);
                *(LAS u32x4*)(Vs + ((tid >> 4) + 32 * i) * MC_S + vpart * 8) = w;
            }
            if (tid < 16) { u32x4 w; w.x = pk2(zf[0], zf[1]); w.y = pk2(zf[2], zf[3]); w.z = pk2(zf[4], zf[5]); w.w = pk2(zf[6], zf[7]); *(LAS u32x4*)(Vs + 128 * MC_S + vpart * 8) = w; }
#pragma unroll
            for (int i = 0; i < 4; ++i) *(LAS u32x4*)(Ks + ((tid >> 4) + 32 * i) * MC_S + vpart * 8) = pk[i];
        }
        const float rfq = fast_exp2(rtq - Rend);
        __syncthreads();
        f32x4 o[9];
        if (sidx) {
#pragma unroll
            for (int nt = 0; nt < 9; ++nt) {
                f32x4 acc = (f32x4){0.f, 0.f, 0.f, 0.f};
#pragma unroll
                for (int ks = 0; ks < 4; ++ks) { const bf16x8 b = *(const LAS bf16x8*)(RT + (nt * 16 + l15) * MC_S + ks * 32 + quad * 8);
                    acc = __builtin_amdgcn_mfma_f32_16x16x32_bf16(qf[ks], b, acc, 0, 0, 0); }
                o[nt] = acc;
            }
            const f32x4 rt4 = *(const f32x4*)(ROWT + sbase + cj * 128 + wave * 16 + quad * 4);
#pragma unroll
            for (int r = 0; r < 4; ++r) { const float cf = fast_exp2(rt4[r] - Rprev);
#pragma unroll
                for (int nt = 0; nt < 9; ++nt) o[nt][r] *= cf; }
        } else {
#pragma unroll
            for (int nt = 0; nt < 9; ++nt) o[nt] = (f32x4){0.f, 0.f, 0.f, 0.f};
        }
        f32x4 sT[8];
#pragma unroll
        for (int kt = 0; kt < 8; ++kt) {
            f32x4 sa = (f32x4){0.f, 0.f, 0.f, 0.f};
#pragma unroll
            for (int ks = 0; ks < 4; ++ks) { const bf16x8 a = *(const LAS bf16x8*)(Ks + (kt * 16 + l15) * MC_S + ks * 32 + quad * 8);
                sa = __builtin_amdgcn_mfma_f32_16x16x32_bf16(a, qf[ks], sa, 0, 0, 0); }
#pragma unroll
            for (int r = 0; r < 4; ++r) { const int kpos = kt * 16 + quad * 4 + r; const bool ok = dir ? (kpos >= qpos) : (kpos <= qpos); sa[r] = ok ? sa[r] * rfq : 0.f; }
            sT[kt] = sa;
        }
        if (sidx + 1 < 18) {
            const size_t tokn = rowbase + (size_t)MC_CJ(sidx + 1) * 128;
#pragma unroll
            for (int ks = 0; ks < 4; ++ks) qf[ks] = *(const bf16x8*)((const char*)(QC + tokn * 512 + h * 128) + (unsigned)((qpos * 512 + quad * 8) * 2) + ks * 64);
        }
#pragma unroll
        for (int i = 0; i < 4; ++i) {
            u32x4 pw; pw.x = cvt_pk_bf16(sT[2 * i][0], sT[2 * i][1]); pw.y = cvt_pk_bf16(sT[2 * i][2], sT[2 * i][3]);
            pw.z = cvt_pk_bf16(sT[2 * i + 1][0], sT[2 * i + 1][1]); pw.w = cvt_pk_bf16(sT[2 * i + 1][2], sT[2 * i + 1][3]);
            const bf16x8 pa = __builtin_bit_cast(bf16x8, pw);
#pragma unroll
            for (int nt = 0; nt < 9; ++nt) {
                const u32x2 lo = *(const LAS u32x2*)(Vs + (nt * 16 + l15) * MC_S + i * 32 + quad * 4);
                const u32x2 hi = *(const LAS u32x2*)(Vs + (nt * 16 + l15) * MC_S + i * 32 + 16 + quad * 4);
                u32x4 bw; bw.x = lo.x; bw.y = lo.y; bw.z = hi.x; bw.w = hi.y;
                o[nt] = __builtin_amdgcn_mfma_f32_16x16x32_bf16(pa, __builtin_bit_cast(bf16x8, bw), o[nt], 0, 0, 0);
            }
        }
        {
            const f32x4 en4 = *(const f32x4*)(ENM + sbase + cj * 128 + wave * 16 + quad * 4);
#pragma unroll
            for (int r = 0; r < 4; ++r) {
                const float den = shfl_idx(o[8][r], quad * 16);
                const float inv = 1.0f / fmaxf(fabsf(den), en4[r]);
                bf16_t* orow = (bf16_t*)((char*)(RO + tok0 * 512 + h * 128) + (unsigned)(((wave * 16 + quad * 4 + r) * 512 + l15) * 2));
#pragma unroll
                for (int nt = 0; nt < 8; ++nt) orow[nt * 16] = (bf16_t)f2bf(o[nt][r] * inv);
            }
        }
        (void)enq;
        __syncthreads();
        if (sidx + 1 < 18) {
            const int cjn = MC_CJ(sidx + 1); const size_t tokn = rowbase + (size_t)cjn * 128;
            const char* vbase = (const char*)(VT + (size_t)(h * 128) * TG + tokn);
            const unsigned voff = (unsigned)(tid >> 4) * (unsigned)(TG * 2) + (unsigned)vpart * 16u;
            const char* kbase = (const char*)(KC + tokn * 512 + h * 128);
            const unsigned koff = (unsigned)(((tid >> 4) * 512 + vpart * 8) * 2);
#pragma unroll
            for (int i = 0; i < 4; ++i) pv[i] = *(const u32x4*)(vbase + (size_t)i * 32 * TG * 2 + voff);
#pragma unroll
            for (int i = 0; i < 4; ++i) pk[i] = *(const u32x4*)(kbase + (size_t)i * 32 * 512 * 2 + koff);
            cz[0] = *(const f32x4*)(COLT + sbase + cjn * 128 + vpart * 8); cz[1] = *(const f32x4*)(COLT + sbase + cjn * 128 + vpart * 8 + 4);
        }
        {
            const float decay = fast_exp2(Rend - Rprev);
#pragma unroll
            for (int mt = 0; mt < 9; ++mt) st[mt] = st[mt] * decay;
#pragma unroll
            for (int ks = 0; ks < 4; ++ks) {
                u32x4 bw;
                { const LAS bf16_t* kp = Ks + (ks * 32 + quad * 8) * MC_S + wave * 16 + l15;
                  bw.x = (unsigned)kp[0 * MC_S] | ((unsigned)kp[1 * MC_S] << 16); bw.y = (unsigned)kp[2 * MC_S] | ((unsigned)kp[3 * MC_S] << 16);
                  bw.z = (unsigned)kp[4 * MC_S] | ((unsigned)kp[5 * MC_S] << 16); bw.w = (unsigned)kp[6 * MC_S] | ((unsigned)kp[7 * MC_S] << 16); }
                const bf16x8 b = __builtin_bit_cast(bf16x8, bw);
#pragma unroll
                for (int mt = 0; mt < 9; ++mt) { const bf16x8 a = *(const LAS bf16x8*)(Vs + (mt * 16 + l15) * MC_S + ks * 32 + quad * 8);
                    st[mt] = __builtin_amdgcn_mfma_f32_16x16x32_bf16(a, b, st[mt], 0, 0, 0); }
            }
#pragma unroll
            for (int mt = 0; mt < 9; ++mt)
#pragma unroll
                for (int r = 0; r < 4; ++r) RT[(mt * 16 + quad * 4 + r) * MC_S + wave * 16 + l15] = (bf16_t)f2bf(st[mt][r]);
        }
    }
#undef MC_CJ
#undef MC_J
}
__device__ __forceinline__ void mlstm_post_row(const P& p, int r, int lane) {
    const bf16_t* RF = (const bf16_t*)(p.ws + OFF_RF) + (size_t)r * 512; const bf16_t* RB = (const bf16_t*)(p.ws + OFF_RB) + (size_t)r * 512;
    const bf16_t* OG = (const bf16_t*)(p.ws + OFF_PN) + (size_t)r * 2048 + 1024;
    bf16_t* CAT = (bf16_t*)(p.ws + OFF_H) + (size_t)r * 1024 + 512;
    const int c0 = lane * 8;
    const f32x4 h0 = *(const f32x4*)(p.ab_head_g + c0), h1 = *(const f32x4*)(p.ab_head_g + c0 + 4);
    float a[2][8];
#pragma unroll
    for (int q = 0; q < 2; ++q) {
        float b[8], g[8]; unpack8(__builtin_nontemporal_load((const u32x4*)(RF + q * 512 + c0)), a[q]); unpack8(__builtin_nontemporal_load((const u32x4*)(RB + q * 512 + c0)), b);
        unpack8(__builtin_nontemporal_load((const u32x4*)(OG + q * 2048 + c0)), g);
#pragma unroll
        for (int i = 0; i < 8; ++i) a[q][i] = (a[q][i] + b[i]) * g[i];
    }
#pragma unroll
    for (int q = 0; q < 2; ++q) {
        float s = 0.f;
#pragma unroll
        for (int i = 0; i < 8; ++i) s += a[q][i];
        s += shfl_xor_l(s, 1, lane); s += shfl_xor_l(s, 2, lane); s += shfl_xor_l(s, 4, lane); s += shfl_xor_l(s, 8, lane);
        const float mean = s * (1.0f / 128.0f); float qq = 0.f;
#pragma unroll
        for (int i = 0; i < 8; ++i) { a[q][i] -= mean; qq += a[q][i] * a[q][i]; }
        qq += shfl_xor_l(qq, 1, lane); qq += shfl_xor_l(qq, 2, lane); qq += shfl_xor_l(qq, 4, lane); qq += shfl_xor_l(qq, 8, lane);
        const float rstd = rsqrtf(qq * (1.0f / 128.0f) + 1e-6f);
        u32x4 w; w.x = pk2(a[q][0] * rstd * h0[0], a[q][1] * rstd * h0[1]); w.y = pk2(a[q][2] * rstd * h0[2], a[q][3] * rstd * h0[3]);
        w.z = pk2(a[q][4] * rstd * h1[0], a[q][5] * rstd * h1[1]); w.w = pk2(a[q][6] * rstd * h1[2], a[q][7] * rstd * h1[3]);
        *(u32x4*)(CAT + q * 1024 + c0) = w;
    }
}

__device__ __forceinline__ void sgu_item(const P& p, int bl, int chunk, int g, const int tid) {
    const int wave = __builtin_amdgcn_readfirstlane(tid >> 6), lane = tid & 63, l15 = lane & 15, quad = lane >> 4;
    const bf16_t* SW = (const bf16_t*)(p.ws + OFF_SGUW); const bf16_t* VT = (const bf16_t*)(p.ws + OFF_VT0);
    const bf16_t* PN = (const bf16_t*)(p.ws + OFF_PN); bf16_t* CAT = (bf16_t*)(p.ws + OFF_H);
    const size_t tok0 = (size_t)bl * LT + chunk * 128;
    bf16x8 af[4];
#pragma unroll
    for (int ks = 0; ks < 4; ++ks) af[ks] = *(const bf16x8*)(SW + (size_t)(g * 128 + wave * 16 + l15) * 128 + ks * 32 + quad * 8);
#pragma unroll 2
    for (int nt = 0; nt < 8; ++nt) {
        f32x4 acc = (f32x4){0.f, 0.f, 0.f, 0.f};
#pragma unroll
        for (int ks = 0; ks < 4; ++ks) {
            const bf16x8 b = *(const bf16x8*)(VT + (size_t)(512 + g * 128 + nt * 16 + l15) * TG + tok0 + ks * 32 + quad * 8);
            acc = __builtin_amdgcn_mfma_f32_16x16x32_bf16(af[ks], b, acc, 0, 0, 0);
        }
#pragma unroll
        for (int r = 0; r < 4; ++r) {
            const int pp = wave * 16 + quad * 4 + r; const size_t tok = tok0 + pp;
            const float uu = bf2f(PN[tok * 2048 + 1536 + g * 128 + nt * 16 + l15]);
            CAT[tok * 1024 + g * 128 + nt * 16 + l15] = (bf16_t)f2bf((acc[r] + p.ab_sgu_b[g * 128 + pp]) * uu);
        }
    }
}

constexpr int RC_VS = 136, RC_RS = 264, RC_KS = 264, RC_KTS = 136;
constexpr int RC_OFF_V = 0, RC_OFF_RT = RC_OFF_V + 128 * RC_VS * 2, RC_OFF_KT = RC_OFF_RT, RC_OFF_KH = RC_OFF_KT + 256 * RC_KTS * 2;
static_assert(RC_OFF_KH + 64 * RC_KS * 2 <= LDS_BYTES - 64, "retention LDS");
static_assert(RC_OFF_RT + 128 * RC_RS * 2 <= RC_OFF_KH, "retention LDS overlay");
__device__ __forceinline__ void ret_chunk_item(const P& p, LAS unsigned char* lds, int bl, int h, int vs, const int tid) {
    const int wave = __builtin_amdgcn_readfirstlane(tid >> 6), lane = tid & 63, l15 = lane & 15, quad = lane >> 4;
    const bf16_t* Q1 = (const bf16_t*)(p.ws + OFF_Q1); const bf16_t* K1 = (const bf16_t*)(p.ws + OFF_K1); const bf16_t* VT = (const bf16_t*)(p.ws + OFF_VT1);
    const bf16_t* K1T = (const bf16_t*)(p.ws + OFF_K1T);
    LAS bf16_t* Vs = (LAS bf16_t*)(lds + RC_OFF_V); LAS bf16_t* RT = (LAS bf16_t*)(lds + RC_OFF_RT);
    LAS bf16_t* KTs = (LAS bf16_t*)(lds + RC_OFF_KT); LAS bf16_t* KH = (LAS bf16_t*)(lds + RC_OFF_KH);
    const size_t rowbase = (size_t)bl * LT;
#define RC_CJ(sx) (dir == 0 ? (sx) : ((sx) < 2 ? 1 - (sx) : 19 - (sx)))
#pragma unroll 1
    for (int dir = 0; dir < 2; ++dir) {
        bf16_t* RO = (bf16_t*)(p.ws + (dir ? OFF_MRG2 : OFF_MRG));
        const float dl = p.ret_decay[dir * 4 + h];
        const float lg2 = logsig(dl) * LOG2E;
        const float g128 = fast_exp2(lg2 * 128.0f);
        f32x4 st[2][8];
#pragma unroll
        for (int mt = 0; mt < 2; ++mt)
#pragma unroll
            for (int nt = 0; nt < 8; ++nt) st[mt][nt] = (f32x4){0.f, 0.f, 0.f, 0.f};
        u32x4 pv[4], pk[4]; bf16x8 qf[8];
        {
            int t0 = tid; asm volatile("" : "+v"(t0)); const int tid = t0;
            const size_t tok0 = rowbase + (size_t)RC_CJ(0) * 128;
            const u32x4* vp = (const u32x4*)((const char*)(VT + (size_t)(h * 512 + vs * 128) * TG + tok0) + ((unsigned)(tid >> 2) * (unsigned)(TG * 2) + (unsigned)(tid & 3) * 64u));
            const u32x4* kp = (const u32x4*)((const char*)(K1 + tok0 * 1024 + h * 256) + (unsigned)(((tid >> 3) * 1024 + (tid & 7) * 32) * 2));
#pragma unroll
            for (int i = 0; i < 4; ++i) pv[i] = vp[i];
#pragma unroll
            for (int i = 0; i < 4; ++i) pk[i] = kp[i];
        }
#pragma unroll 1
        for (int sidx = 0; sidx < 18; ++sidx) {
            const int cj = RC_CJ(sidx);
            const bool is_lat = cj >= 2;
            const size_t tok0 = rowbase + (size_t)cj * 128;
            int tl = tid; asm volatile("" : "+v"(tl));
            const int tid = tl, lane = tid & 63, l15 = lane & 15, quad = lane >> 4, vpart = tid & 15;
            const unsigned ktoff = (unsigned)(tid >> 2) * (unsigned)(TG * 2) + (unsigned)(tid & 3) * 64u;
            const unsigned khoff = (unsigned)(((tid >> 3) * 1024 + (tid & 7) * 32) * 2);
            const int qpos = wave * 16 + l15;
            __syncthreads();
            {
                const int p0 = (tid & 3) * 32;
                float z = fast_exp2(lg2 * (float)(dir ? p0 : 127 - p0));
                const float zstep = fast_exp2(dir ? lg2 : -lg2);
#pragma unroll
                for (int i = 0; i < 4; ++i) {
                    float f[8]; unpack8(pv[i], f);
#pragma unroll
                    for (int e = 0; e < 8; ++e) { f[e] *= z; z *= zstep; }
                    u32x4 w; w.x = pk2(f[0], f[1]); w.y = pk2(f[2], f[3]); w.z = pk2(f[4], f[5]); w.w = pk2(f[6], f[7]);
                    *(LAS u32x4*)(Vs + (tid >> 2) * RC_VS + p0 + i * 8) = w;
                }
#pragma unroll
                for (int i = 0; i < 4; ++i) *(LAS u32x4*)(KH + (tid >> 3) * RC_KS + (tid & 7) * 32 + i * 8) = pk[i];
            }
            __syncthreads();
            f32x4 o[8];
#pragma unroll 1
            for (int hf = 0; hf < 2; ++hf) {
                if (hf == 0) {
#pragma unroll
                    for (int i = 0; i < 4; ++i) pk[i] = ((const u32x4*)((const char*)(K1 + (tok0 + 64) * 1024 + h * 256) + khoff))[i];
                } else {
                    __syncthreads();
#pragma unroll
                    for (int i = 0; i < 4; ++i) *(LAS u32x4*)(KH + (tid >> 3) * RC_KS + (tid & 7) * 32 + i * 8) = pk[i];
                    __syncthreads();
                    if (sidx + 1 < 18) {
                        const size_t tokn = rowbase + (size_t)RC_CJ(sidx + 1) * 128;
#pragma unroll
                        for (int i = 0; i < 4; ++i) pk[i] = ((const u32x4*)((const char*)(K1 + tokn * 1024 + h * 256) + khoff))[i];
                    }
                }
                if (is_lat) {
                    if (hf == 0) {
#pragma unroll
                        for (int nt = 0; nt < 8; ++nt) {
                            f32x4 acc = (f32x4){0.f, 0.f, 0.f, 0.f};
#pragma unroll
                            for (int ks = 0; ks < 8; ++ks) { const bf16x8 b = *(const LAS bf16x8*)(RT + (nt * 16 + l15) * RC_RS + ks * 32 + quad * 8);
                                acc = __builtin_amdgcn_mfma_f32_16x16x32_bf16(qf[ks], b, acc, 0, 0, 0); }
#pragma unroll
                            for (int r = 0; r < 4; ++r) { const int pos = wave * 16 + quad * 4 + r; acc[r] *= fast_exp2(lg2 * (float)((dir ? 127 - pos : pos) + 1)); }
                            o[nt] = acc;
                            __builtin_amdgcn_sched_barrier(0);
                        }
                    }
                    f32x4 sT[4];
#pragma unroll
                    for (int kt = 0; kt < 4; ++kt) {
                        f32x4 sa = (f32x4){0.f, 0.f, 0.f, 0.f};
#pragma unroll
                        for (int ks = 0; ks < 8; ++ks) { const bf16x8 a = *(const LAS bf16x8*)(KH + (kt * 16 + l15) * RC_KS + ks * 32 + quad * 8);
                            sa = __builtin_amdgcn_mfma_f32_16x16x32_bf16(a, qf[ks], sa, 0, 0, 0); }
                        sT[kt] = sa;
                        __builtin_amdgcn_sched_barrier(0);
                    }
                    if (hf == 1 && sidx + 1 < 18 && RC_CJ(sidx + 1) >= 2) {
                        const size_t tokn = rowbase + (size_t)RC_CJ(sidx + 1) * 128;
#pragma unroll
                        for (int ks = 0; ks < 8; ++ks) qf[ks] = *(const bf16x8*)((const char*)(Q1 + tokn * 1024 + h * 256) + (unsigned)((qpos * 1024 + quad * 8) * 2) + ks * 64);
                    }
                    const float rsq = fast_exp2(lg2 * (float)((dir ? 127 - qpos : qpos) - 127));
#pragma unroll
                    for (int kt = 0; kt < 4; ++kt)
#pragma unroll
                        for (int r = 0; r < 4; ++r) { const int kpos = hf * 64 + kt * 16 + quad * 4 + r;
                            const bool ok = dir ? (kpos >= qpos) : (kpos <= qpos);
                            sT[kt][r] = ok ? sT[kt][r] * rsq : 0.f; }
#pragma unroll
                    for (int i = 0; i < 2; ++i) {
                        u32x4 pw; pw.x = cvt_pk_bf16(sT[2 * i][0], sT[2 * i][1]); pw.y = cvt_pk_bf16(sT[2 * i][2], sT[2 * i][3]);
                        pw.z = cvt_pk_bf16(sT[2 * i + 1][0], sT[2 * i + 1][1]); pw.w = cvt_pk_bf16(sT[2 * i + 1][2], sT[2 * i + 1][3]);
                        const bf16x8 pa = __builtin_bit_cast(bf16x8, pw);
#pragma unroll
                        for (int nt = 0; nt < 8; ++nt) {
                            const u32x2 lo = *(const LAS u32x2*)(Vs + (nt * 16 + l15) * RC_VS + hf * 64 + i * 32 + quad * 4);
                            const u32x2 hi = *(const LAS u32x2*)(Vs + (nt * 16 + l15) * RC_VS + hf * 64 + i * 32 + 16 + quad * 4);
                            u32x4 bw; bw.x = lo.x; bw.y = lo.y; bw.z = hi.x; bw.w = hi.y;
                            o[nt] = __builtin_amdgcn_mfma_f32_16x16x32_bf16(pa, __builtin_bit_cast(bf16x8, bw), o[nt], 0, 0, 0);
                        }
                    }
                    if (hf == 1) {
#pragma unroll
                        for (int r = 0; r < 4; ++r) {
                            bf16_t* orow = (bf16_t*)((char*)(RO + ((size_t)bl * SEQ + (cj - 2) * 128) * 2048 + h * 512 + vs * 128) + (unsigned)(((wave * 16 + quad * 4 + r) * 2048 + l15) * 2));
#pragma unroll
                            for (int nt = 0; nt < 8; ++nt) orow[nt * 16] = (bf16_t)f2bf(o[nt][r]);
                        }
                    }
                } else if (hf == 1 && sidx + 1 < 18 && RC_CJ(sidx + 1) >= 2) {
                    const size_t tokn = rowbase + (size_t)RC_CJ(sidx + 1) * 128;
#pragma unroll
                    for (int ks = 0; ks < 8; ++ks) qf[ks] = *(const bf16x8*)((const char*)(Q1 + tokn * 1024 + h * 256) + (unsigned)((qpos * 1024 + quad * 8) * 2) + ks * 64);
                }
                if (hf == 1 && sidx + 1 < 18) {
                    const size_t tokn = rowbase + (size_t)RC_CJ(sidx + 1) * 128;
                    const char* vbase = (const char*)(VT + (size_t)(h * 512 + vs * 128) * TG + tokn);
#pragma unroll
                    for (int i = 0; i < 4; ++i) pv[i] = ((const u32x4*)(vbase + ktoff))[i];
                }
                if (hf == 0) {
#pragma unroll
                    for (int mt = 0; mt < 2; ++mt)
#pragma unroll
                        for (int nt = 0; nt < 8; ++nt) st[mt][nt] = st[mt][nt] * g128;
                }
#pragma unroll
                for (int ks2 = 0; ks2 < 2; ++ks2) {
#pragma unroll
                    for (int mt = 0; mt < 2; ++mt) {
                        u32x4 aw;
                        { const LAS bf16_t* kp = KH + (ks2 * 32 + quad * 8) * RC_KS + wave * 32 + mt * 16 + l15;
                          aw.x = (unsigned)kp[0 * RC_KS] | ((unsigned)kp[1 * RC_KS] << 16); aw.y = (unsigned)kp[2 * RC_KS] | ((unsigned)kp[3 * RC_KS] << 16);
                          aw.z = (unsigned)kp[4 * RC_KS] | ((unsigned)kp[5 * RC_KS] << 16); aw.w = (unsigned)kp[6 * RC_KS] | ((unsigned)kp[7 * RC_KS] << 16); }
                        const bf16x8 a = __builtin_bit_cast(bf16x8, aw);
#pragma unroll
                        for (int nt = 0; nt < 8; ++nt) { const bf16x8 b = *(const LAS bf16x8*)(Vs + (nt * 16 + l15) * RC_VS + hf * 64 + ks2 * 32 + quad * 8);
                            st[mt][nt] = __builtin_amdgcn_mfma_f32_16x16x32_bf16(a, b, st[mt][nt], 0, 0, 0); }
                        __builtin_amdgcn_sched_barrier(0);
                    }
                }
            }
#pragma unroll
            for (int mt = 0; mt < 2; ++mt)
#pragma unroll
                for (int nt = 0; nt < 8; ++nt) { u32x2 w; w.x = cvt_pk_bf16(st[mt][nt][0], st[mt][nt][1]); w.y = cvt_pk_bf16(st[mt][nt][2], st[mt][nt][3]);
                    *(LAS u32x2*)(RT + (nt * 16 + l15) * RC_RS + wave * 32 + mt * 16 + quad * 4) = w; }
        }
    }
#undef RC_CJ
}
__device__ __forceinline__ void ret_post_row(const P& p, int rl, int lane) {
    bf16_t* row = (bf16_t*)(p.ws + OFF_MRG) + (size_t)rl * 2048;
    const bf16_t* row2 = (const bf16_t*)(p.ws + OFF_MRG2) + (size_t)rl * 2048;
    const int bl = rl / SEQ, t = rl % SEQ;
    const bf16_t* grow = (const bf16_t*)(p.ws + OFF_G1) + ((size_t)bl * LT + 256 + t) * 2048;
#pragma unroll
    for (int hh = 0; hh < 4; ++hh) {
        const int c0 = hh * 512 + lane * 8;
        const f32x4 h0 = *(const f32x4*)(p.ret_head_g + c0), h1 = *(const f32x4*)(p.ret_head_g + c0 + 4);
        float v[2][8], gv[2][8];
#pragma unroll
        for (int q = 0; q < 2; ++q) {
            float v2[8]; unpack8(__builtin_nontemporal_load((const u32x4*)(row + q * 2048 + c0)), v[q]); unpack8(__builtin_nontemporal_load((const u32x4*)(row2 + q * 2048 + c0)), v2);
            unpack8(__builtin_nontemporal_load((const u32x4*)(grow + q * 2048 + c0)), gv[q]);
#pragma unroll
            for (int i = 0; i < 8; ++i) v[q][i] += v2[i];
        }
#pragma unroll
        for (int q = 0; q < 2; ++q) {
            float s = 0.f;
#pragma unroll
            for (int i = 0; i < 8; ++i) s += v[q][i];
            const float mean = wave_sum(s, lane) * (1.0f / 512.0f);
            float qq = 0.f;
#pragma unroll
            for (int i = 0; i < 8; ++i) { v[q][i] -= mean; qq += v[q][i] * v[q][i]; }
            const float rstd = rsqrtf(wave_sum(qq, lane) * (1.0f / 512.0f) + 1e-6f);
            u32x4 w; w.x = pk2(v[q][0] * rstd * h0[0] * gv[q][0], v[q][1] * rstd * h0[1] * gv[q][1]); w.y = pk2(v[q][2] * rstd * h0[2] * gv[q][2], v[q][3] * rstd * h0[3] * gv[q][3]);
            w.z = pk2(v[q][4] * rstd * h1[0] * gv[q][4], v[q][5] * rstd * h1[1] * gv[q][5]); w.w = pk2(v[q][6] * rstd * h1[2] * gv[q][6], v[q][7] * rstd * h1[3] * gv[q][7]);
            *(u32x4*)(row + q * 2048 + c0) = w;
        }
    }
}

template <bool GATES>
__device__ __forceinline__ void row_pass(const float* xsrc, const bf16_t* y, float* xdst, bf16_t* hrow, const float* postg, const float* mg,
                                         const float* preg, const float* msh, const float* msc, int lane,
                                         const LAS float* wgT = nullptr, const float* gate_b = nullptr, float* grow = nullptr) {
    f32x4 v[4];
#pragma unroll
    for (int j = 0; j < 4; ++j) v[j] = __builtin_nontemporal_load((const f32x4*)(xsrc + lane * 4 + 256 * j));
    if (y) {
        f32x4 yv[4]; float ss = 0.f;
#pragma unroll
        for (int j = 0; j < 4; ++j) { const u32x2 w = __builtin_nontemporal_load((const u32x2*)(y + lane * 4 + 256 * j)); yv[j] = (f32x4){bflo(w.x), bfhi(w.x), bflo(w.y), bfhi(w.y)};
            ss += (yv[j][0] * yv[j][0] + yv[j][1] * yv[j][1]) + (yv[j][2] * yv[j][2] + yv[j][3] * yv[j][3]); }
        ss = wave_sum(ss, lane);
        const float ry = rsqrtf(ss * (1.0f / 1024.0f) + 1e-6f);
#pragma unroll
        for (int j = 0; j < 4; ++j) { const f32x4 pg = *(const f32x4*)(postg + lane * 4 + 256 * j), gg = *(const f32x4*)(mg + lane * 4 + 256 * j);
            v[j] = v[j] + gg * (yv[j] * ry * pg); }
        if (xdst) {
#pragma unroll
            for (int j = 0; j < 4; ++j) __builtin_nontemporal_store(v[j], (f32x4*)(xdst + lane * 4 + 256 * j));
        }
    }
    if (hrow) {
        float ss = 0.f;
#pragma unroll
        for (int j = 0; j < 4; ++j) ss += (v[j][0] * v[j][0] + v[j][1] * v[j][1]) + (v[j][2] * v[j][2] + v[j][3] * v[j][3]);
        ss = wave_sum(ss, lane);
        const float rx = rsqrtf(ss * (1.0f / 1024.0f) + 1e-6f);
#pragma unroll
        for (int j = 0; j < 4; ++j) { const f32x4 pr = *(const f32x4*)(preg + lane * 4 + 256 * j), sh = *(const f32x4*)(msh + lane * 4 + 256 * j), sc = *(const f32x4*)(msc + lane * 4 + 256 * j);
            const f32x4 hv = v[j] * rx * pr * (sc + 1.0f) + sh;
            if (GATES) v[j] = hv;
            u32x2 w; w.x = pk2(hv[0], hv[1]); w.y = pk2(hv[2], hv[3]);
            __builtin_nontemporal_store(w, (u32x2*)(hrow + lane * 4 + 256 * j)); }
        if (GATES) {
            float mine = 0.f;
#pragma unroll 2
            for (int g = 0; g < 16; ++g) {
                float s = 0.f;
#pragma unroll
                for (int j = 0; j < 4; ++j) { const f32x4 w = *(const LAS f32x4*)(wgT + g * 1024 + lane * 4 + 256 * j);
                    s += (v[j][0] * w[0] + v[j][1] * w[1]) + (v[j][2] * w[2] + v[j][3] * w[3]); }
                s = wave_sum(s, lane);
                if (lane == g) mine = s;
            }
            if (lane < 16) grow[lane] = mine + gate_b[lane];
        }
    }
}

template <bool GATES>
__device__ __forceinline__ void row_pass2(const float* xsrc, const bf16_t* y, float* xdst, bf16_t* hrow, const float* postg, const float* mg,
                                          const float* preg, const float* msh, const float* msc, int lane,
                                          const LAS float* wgT = nullptr, const float* gate_b = nullptr, float* grow = nullptr) {
    f32x4 v[2][4];
#pragma unroll
    for (int q = 0; q < 2; ++q)
#pragma unroll
        for (int j = 0; j < 4; ++j) v[q][j] = __builtin_nontemporal_load((const f32x4*)(xsrc + q * 1024 + lane * 4 + 256 * j));
    if (y) {
        f32x4 yv[2][4]; float ss[2] = {0.f, 0.f};
#pragma unroll
        for (int q = 0; q < 2; ++q)
#pragma unroll
            for (int j = 0; j < 4; ++j) { const u32x2 w = __builtin_nontemporal_load((const u32x2*)(y + q * 1024 + lane * 4 + 256 * j)); yv[q][j] = (f32x4){bflo(w.x), bfhi(w.x), bflo(w.y), bfhi(w.y)};
                ss[q] += (yv[q][j][0] * yv[q][j][0] + yv[q][j][1] * yv[q][j][1]) + (yv[q][j][2] * yv[q][j][2] + yv[q][j][3] * yv[q][j][3]); }
        ss[0] = wave_sum(ss[0], lane); ss[1] = wave_sum(ss[1], lane);
        const float ry0 = rsqrtf(ss[0] * (1.0f / 1024.0f) + 1e-6f), ry1 = rsqrtf(ss[1] * (1.0f / 1024.0f) + 1e-6f);
#pragma unroll
        for (int j = 0; j < 4; ++j) { const f32x4 pg = *(const f32x4*)(postg + lane * 4 + 256 * j), gg = *(const f32x4*)(mg + lane * 4 + 256 * j);
            v[0][j] = v[0][j] + gg * (yv[0][j] * ry0 * pg); v[1][j] = v[1][j] + gg * (yv[1][j] * ry1 * pg); }
        if (xdst) {
#pragma unroll
            for (int q = 0; q < 2; ++q)
#pragma unroll
                for (int j = 0; j < 4; ++j) __builtin_nontemporal_store(v[q][j], (f32x4*)(xdst + q * 1024 + lane * 4 + 256 * j));
        }
    }
    if (hrow) {
        float ss[2] = {0.f, 0.f};
#pragma unroll
        for (int q = 0; q < 2; ++q)
#pragma unroll
            for (int j = 0; j < 4; ++j) ss[q] += (v[q][j][0] * v[q][j][0] + v[q][j][1] * v[q][j][1]) + (v[q][j][2] * v[q][j][2] + v[q][j][3] * v[q][j][3]);
        ss[0] = wave_sum(ss[0], lane); ss[1] = wave_sum(ss[1], lane);
        const float rx[2] = {rsqrtf(ss[0] * (1.0f / 1024.0f) + 1e-6f), rsqrtf(ss[1] * (1.0f / 1024.0f) + 1e-6f)};
#pragma unroll
        for (int j = 0; j < 4; ++j) { const f32x4 pr = *(const f32x4*)(preg + lane * 4 + 256 * j), sh = *(const f32x4*)(msh + lane * 4 + 256 * j), sc = *(const f32x4*)(msc + lane * 4 + 256 * j);
#pragma unroll
            for (int q = 0; q < 2; ++q) {
                const f32x4 hv = v[q][j] * rx[q] * pr * (sc + 1.0f) + sh;
                if (GATES) v[q][j] = hv;
                u32x2 w; w.x = pk2(hv[0], hv[1]); w.y = pk2(hv[2], hv[3]);
                __builtin_nontemporal_store(w, (u32x2*)(hrow + q * 1024 + lane * 4 + 256 * j)); } }
        if (GATES) {
            float mine0 = 0.f, mine1 = 0.f;
#pragma unroll 2
            for (int g = 0; g < 16; ++g) {
                float s0 = 0.f, s1 = 0.f;
#pragma unroll
                for (int j = 0; j < 4; ++j) { const f32x4 w = *(const LAS f32x4*)(wgT + g * 1024 + lane * 4 + 256 * j);
                    s0 += (v[0][j][0] * w[0] + v[0][j][1] * w[1]) + (v[0][j][2] * w[2] + v[0][j][3] * w[3]);
                    s1 += (v[1][j][0] * w[0] + v[1][j][1] * w[1]) + (v[1][j][2] * w[2] + v[1][j][3] * w[3]); }
                s0 = wave_sum(s0, lane); s1 = wave_sum(s1, lane);
                if (lane == g) { mine0 = s0; mine1 = s1; }
            }
            if (lane < 16) { grow[lane] = mine0 + gate_b[lane]; grow[16 + lane] = mine1 + gate_b[lane]; }
        }
    }
}

__device__ __forceinline__ void transpose_item(const float* W, int ldsrc, int K, bf16_t* WT, int nblk, LAS float* scr, int item, int lane) {
    const int kb = item / nblk, nb = item % nblk, k0 = 64 * kb, n0 = 32 * nb;
#pragma unroll 8
    for (int i = 0; i < 32; ++i) { const int kk = 2 * i + (lane >> 5); scr[kk * 33 + (lane & 31)] = W[(size_t)(k0 + kk) * ldsrc + n0 + (lane & 31)]; }
    LDS_WAIT();
    const int c = lane & 7;
#pragma unroll
    for (int j = 0; j < 4; ++j) { const int n = (lane >> 3) + 8 * j; const LAS float* s = scr + (8 * c) * 33 + n;
        u32x4 o; o.x = pk2(s[0 * 33], s[1 * 33]); o.y = pk2(s[2 * 33], s[3 * 33]); o.z = pk2(s[4 * 33], s[5 * 33]); o.w = pk2(s[6 * 33], s[7 * 33]);
        *(u32x4*)(WT + (size_t)(n0 + n) * K + k0 + 8 * c) = o; }
    LDS_WAIT();
}

__device__ __forceinline__ void ada_item(const P& p, LAS unsigned char* lds, int it, const int tid) {
    const int col = tid & 63, kg = __builtin_amdgcn_readfirstlane(tid >> 6);
    const int l = it / 96, n0 = (it % 96) * 64;
    LAS float* S = (LAS float*)lds;
    float acc[36];
#pragma unroll
    for (int r = 0; r < 36; ++r) acc[r] = 0.f;
    const float* W = p.ada_w + (size_t)l * 1024 * 6144;
#pragma unroll 1
    for (int kh = 0; kh < 2; ++kh) {
        __syncthreads();
        for (int r = 0; r < 36; ++r) {
            float sv = 0.f;
            if (r < 32) sv = silu_f(p.c[r * 1024 + kh * 512 + tid]); else if (r == 32) sv = silu_f(p.c_ctx[kh * 512 + tid]);
            S[tid * 36 + r] = sv;
        }
        __syncthreads();
#pragma unroll 2
        for (int kk = 0; kk < 64; ++kk) {
            const int kl = kg * 64 + kk;
            const float w = W[(size_t)(kh * 512 + kl) * 6144 + n0 + col];
#pragma unroll
            for (int r4 = 0; r4 < 9; ++r4) { const f32x4 s = *(const LAS f32x4*)(S + kl * 36 + r4 * 4);
                acc[r4 * 4 + 0] += s[0] * w; acc[r4 * 4 + 1] += s[1] * w; acc[r4 * 4 + 2] += s[2] * w; acc[r4 * 4 + 3] += s[3] * w; }
        }
    }
    __syncthreads();
    LAS float* R = (LAS float*)lds;
#pragma unroll
    for (int r = 0; r < 36; ++r) R[(kg * 36 + r) * 64 + col] = acc[r];
    __syncthreads();
    float* MOD = (float*)(p.ws + OFF_MOD);
    for (int idx = tid; idx < 33 * 64; idx += 512) {
        const int r = idx >> 6, cc = idx & 63; float s = 0.f;
#pragma unroll
        for (int k8 = 0; k8 < 8; ++k8) s += R[(k8 * 36 + r) * 64 + cc];
        MOD[(size_t)(l * 33 + r) * 6144 + n0 + cc] = s + p.ada_b[l * 6144 + n0 + cc];
    }
    __syncthreads();
}

__device__ __forceinline__ void prologue(const P& p, LAS unsigned char* lds, const int tid) {
    const int wave = __builtin_amdgcn_readfirstlane(tid >> 6), lane = tid & 63;
    const int G = gridDim.x;
    for (int it = blockIdx.x; it < 192; it += G) ada_item(p, lds, it, tid);
    __syncthreads();
    LAS float* scr = (LAS float*)(lds + wave * 16384);
    const int gw = blockIdx.x * 8 + wave, NGW = G * 8;
    unsigned char* ws = p.ws;
#define SEG(SRC, LDSRC, KK, NC, DST) { const int nblk = (NC) / 32, nit = ((KK) / 64) * nblk; \
        for (int it = gw; it < nit; it += NGW) transpose_item((SRC), (LDSRC), (KK), (DST), nblk, scr, it, lane); }
    SEG(p.ab_w_in + 0,    3088, 1024, 512, (bf16_t*)(ws + OFF_W0N) + (size_t)0 * 1024)
    SEG(p.ab_w_in + 1040, 3088, 1024, 512, (bf16_t*)(ws + OFF_W0N) + (size_t)512 * 1024)
    SEG(p.ab_w_in + 1552, 3088, 1024, 512, (bf16_t*)(ws + OFF_W0N) + (size_t)1024 * 1024)
    SEG(p.ab_w_in + 2064, 3088, 1024, 512, (bf16_t*)(ws + OFF_W0N) + (size_t)1536 * 1024)
    SEG(p.ab_w_in + 512,  3088, 1024, 512, (bf16_t*)(ws + OFF_W0T) + (size_t)0 * 1024)
    SEG(p.ab_w_in + 2576, 3088, 1024, 512, (bf16_t*)(ws + OFF_W0T) + (size_t)512 * 1024)
    SEG(p.ab_w_out, 1024, 1024, 1024, (bf16_t*)(ws + OFF_WO0))
    SEG(p.ffn_up, 5632, 1024, 5632, (bf16_t*)(ws + OFF_WUP0))
    SEG(p.ffn_up + (size_t)1024 * 5632, 5632, 1024, 5632, (bf16_t*)(ws + OFF_WUP1))
    SEG(p.ffn_down, 1024, 2816, 1024, (bf16_t*)(ws + OFF_WDN0))
    SEG(p.ffn_down + (size_t)2816 * 1024, 1024, 2816, 1024, (bf16_t*)(ws + OFF_WDN1))
    SEG(p.ret_w_in + 0,    6144, 1024, 1024, (bf16_t*)(ws + OFF_W1N) + (size_t)0 * 1024)
    SEG(p.ret_w_in + 3072, 6144, 1024, 1024, (bf16_t*)(ws + OFF_W1N) + (size_t)1024 * 1024)
    SEG(p.ret_w_in + 4096, 6144, 1024, 2048, (bf16_t*)(ws + OFF_W1N) + (size_t)2048 * 1024)
    SEG(p.ret_w_in + 1024, 6144, 1024, 2048, (bf16_t*)(ws + OFF_W1T))
    SEG(p.ret_w_out, 1024, 2048, 1024, (bf16_t*)(ws + OFF_WO1))
#undef SEG
    { bf16_t* SW = (bf16_t*)(ws + OFF_SGUW);
      for (int idx = blockIdx.x * 512 + tid; idx < 4 * 128 * 128; idx += G * 512) SW[idx] = (bf16_t)f2bf(p.ab_sgu_w[idx]); }
}


__device__ __forceinline__ void scan_seq(const P& p, int sq, int lane) {
    const float* GT = (const float*)(p.ws + OFF_GATES);
    float* ROWT = (float*)(p.ws + OFF_ROWT); float* COLT = (float*)(p.ws + OFF_COLT); float* ENM = (float*)(p.ws + OFF_ENM);
    const int bl = sq >> 3, h = (sq >> 1) & 3, dir = sq & 1;
    const int gi = (2 * dir) * 4 + h, gf = (2 * dir + 1) * 4 + h;
    const size_t rb = (size_t)bl * LT;
#define JMAP(pp) (dir == 0 ? (pp) : ((pp) < 256 ? 255 - (pp) : 2559 - (pp)))
    float tot = 0.f;
#pragma unroll 6
    for (int e = 0; e < 36; ++e) { const int pp = lane * 36 + e; const int j = JMAP(pp); tot += logsig(GT[(rb + j) * 16 + gf]); }
    float inc = tot;
#pragma unroll
    for (int o = 1; o < 64; o <<= 1) { const float t = shfl_up_l(inc, o, lane); if (lane >= o) inc += t; }
    const float excl = inc - tot;
    float B = excl, mx = -INFINITY;
#pragma unroll 6
    for (int e = 0; e < 36; ++e) { const int pp = lane * 36 + e; const int j = JMAP(pp); B += logsig(GT[(rb + j) * 16 + gf]); mx = fmaxf(mx, GT[(rb + j) * 16 + gi] - B); }
    float incm = mx;
#pragma unroll
    for (int o = 1; o < 64; o <<= 1) { const float t = shfl_up_l(incm, o, lane); if (lane >= o) incm = fmaxf(incm, t); }
    float cm = shfl_up_l(incm, 1, lane); if (lane == 0) cm = -INFINITY;
    B = excl;
#pragma unroll 6
    for (int e = 0; e < 36; ++e) { const int pp = lane * 36 + e; const int j = JMAP(pp);
        B += logsig(GT[(rb + j) * 16 + gf]); const float a = GT[(rb + j) * 16 + gi] - B; cm = fmaxf(cm, a);
        const size_t oi = (size_t)sq * LT + j;
        ROWT[oi] = -cm * LOG2E; COLT[oi] = a * LOG2E; ENM[oi] = fast_exp2(-(B + cm) * LOG2E); }
#undef JMAP
}
__device__ __forceinline__ void conv_row(const P& p, int r, int lane) {
    const bf16_t* PN = (const bf16_t*)(p.ws + OFF_PN);
    const int j = r % LT; const bool hasp = (j != 0 && j != 256), hasn = (j != 255 && j != 2303);
    const int c0 = lane * 8;
#pragma unroll
    for (int which = 0; which < 2; ++which) {
        const int so = which == 0 ? 512 : 0, wo = which == 0 ? 0 : 512;
        bf16_t* dst = (bf16_t*)(p.ws + (which == 0 ? OFF_QC : OFF_KC));
        const float scale = which == 0 ? 1.0f : 0.08838834764831845f;
        float cur[8], prv[8], nxt[8];
        unpack8(*(const u32x4*)(PN + (size_t)r * 2048 + so + c0), cur);
        if (hasp) unpack8(*(const u32x4*)(PN + (size_t)(r - 1) * 2048 + so + c0), prv); else { for (int i = 0; i < 8; ++i) prv[i] = 0.f; }
        if (hasn) unpack8(*(const u32x4*)(PN + (size_t)(r + 1) * 2048 + so + c0), nxt); else { for (int i = 0; i < 8; ++i) nxt[i] = 0.f; }
        float o[8];
#pragma unroll
        for (int i = 0; i < 8; ++i) {
            const float w0 = p.ab_qk_conv[0 * 1024 + wo + c0 + i], w1 = p.ab_qk_conv[1 * 1024 + wo + c0 + i], w2 = p.ab_qk_conv[2 * 1024 + wo + c0 + i];
            o[i] = silu_f(w0 * prv[i] + w1 * cur[i] + w2 * nxt[i]) * scale;
        }
        u32x4 w; w.x = pk2(o[0], o[1]); w.y = pk2(o[2], o[3]); w.z = pk2(o[4], o[5]); w.w = pk2(o[6], o[7]);
        __builtin_nontemporal_store(w, (u32x4*)(dst + (size_t)r * 512 + c0));
    }
}
__device__ __forceinline__ void conv_rows4(const P& p, int r, int lane) {
    const bf16_t* PN = (const bf16_t*)(p.ws + OFF_PN);
    const int j = r % LT; const bool hasp = (j != 0 && j != 256), hasn = (j + 3 != 255 && j + 3 != 2303);
    const int c0 = lane * 8;
#pragma unroll
    for (int which = 0; which < 2; ++which) {
        const int so = which == 0 ? 512 : 0, wo = which == 0 ? 0 : 512;
        bf16_t* dst = (bf16_t*)(p.ws + (which == 0 ? OFF_QC : OFF_KC));
        const float scale = which == 0 ? 1.0f : 0.08838834764831845f;
        float x[6][8];
#pragma unroll
        for (int k = 0; k < 6; ++k) {
            const bool valid = k == 0 ? hasp : (k == 5 ? hasn : true);
            u32x4 v = (u32x4){0u, 0u, 0u, 0u};
            if (valid) v = *(const u32x4*)(PN + (size_t)(r - 1 + k) * 2048 + so + c0);
            unpack8(v, x[k]);
        }
        float w0[8], w1[8], w2[8];
#pragma unroll
        for (int hq = 0; hq < 2; ++hq) {
            const f32x4 a0 = *(const f32x4*)(p.ab_qk_conv + 0 * 1024 + wo + c0 + 4 * hq), a1 = *(const f32x4*)(p.ab_qk_conv + 1 * 1024 + wo + c0 + 4 * hq), a2 = *(const f32x4*)(p.ab_qk_conv + 2 * 1024 + wo + c0 + 4 * hq);
#pragma unroll
            for (int e = 0; e < 4; ++e) { w0[4 * hq + e] = a0[e]; w1[4 * hq + e] = a1[e]; w2[4 * hq + e] = a2[e]; }
        }
#pragma unroll
        for (int o4 = 0; o4 < 4; ++o4) {
            float o[8];
#pragma unroll
            for (int i = 0; i < 8; ++i) o[i] = silu_f(w0[i] * x[o4][i] + w1[i] * x[o4 + 1][i] + w2[i] * x[o4 + 2][i]) * scale;
            u32x4 w; w.x = pk2(o[0], o[1]); w.y = pk2(o[2], o[3]); w.z = pk2(o[4], o[5]); w.w = pk2(o[6], o[7]);
            __builtin_nontemporal_store(w, (u32x4*)(dst + (size_t)(r + o4) * 512 + c0));
        }
    }
}
__device__ __forceinline__ void valn_block(const P& p, LAS unsigned char* lds, int item, const int tid) {
    const int wave = __builtin_amdgcn_readfirstlane(tid >> 6), lane = tid & 63, rs = lane >> 4, tc = lane & 15;
    char* base = (char*)((bf16_t*)(p.ws + OFF_VT0) + (size_t)(512 + wave * 64) * TG + (size_t)item * 128) + ((unsigned)rs * (unsigned)(TG * 2) + (unsigned)tc * 16u);
    LAS float* R = (LAS float*)lds;
    u32x4 val[16];
    float s[8], q[8];
#pragma unroll
    for (int e = 0; e < 8; ++e) { s[e] = 0.f; q[e] = 0.f; }
#pragma unroll
    for (int it = 0; it < 16; ++it) {
        val[it] = *(const u32x4*)(base + (size_t)it * 4 * TG * 2);
        float f[8]; unpack8(val[it], f);
#pragma unroll
        for (int e = 0; e < 8; ++e) { s[e] += f[e]; q[e] += f[e] * f[e]; }
    }
#pragma unroll
    for (int e = 0; e < 8; ++e) { s[e] += shfl_xor_l(s[e], 16, lane); s[e] += shfl_xor_l(s[e], 32, lane); q[e] += shfl_xor_l(q[e], 16, lane); q[e] += shfl_xor_l(q[e], 32, lane); }
    __syncthreads();
    if (rs == 0) {
        LAS f32x4* dst = (LAS f32x4*)(R + (wave * 16 + tc) * 16);
        dst[0] = (f32x4){s[0], s[1], s[2], s[3]}; dst[1] = (f32x4){s[4], s[5], s[6], s[7]}; dst[2] = (f32x4){q[0], q[1], q[2], q[3]}; dst[3] = (f32x4){q[4], q[5], q[6], q[7]};
    }
    __syncthreads();
#pragma unroll
    for (int e = 0; e < 8; ++e) { s[e] = 0.f; q[e] = 0.f; }
#pragma unroll
    for (int w8 = 0; w8 < 8; ++w8) {
        const LAS f32x4* src = (const LAS f32x4*)(R + (w8 * 16 + tc) * 16);
        const f32x4 a0 = src[0], a1 = src[1], b0 = src[2], b1 = src[3];
        s[0] += a0[0]; s[1] += a0[1]; s[2] += a0[2]; s[3] += a0[3]; s[4] += a1[0]; s[5] += a1[1]; s[6] += a1[2]; s[7] += a1[3];
        q[0] += b0[0]; q[1] += b0[1]; q[2] += b0[2]; q[3] += b0[3]; q[4] += b1[0]; q[5] += b1[1]; q[6] += b1[2]; q[7] += b1[3];
    }
    float mean[8], rstd[8];
#pragma unroll
    for (int e = 0; e < 8; ++e) { mean[e] = s[e] * (1.0f / 512.0f); rstd[e] = rsqrtf(fmaxf(q[e] * (1.0f / 512.0f) - mean[e] * mean[e], 0.f) + 1e-6f); }
#pragma unroll
    for (int it = 0; it < 16; ++it) {
        float f[8]; unpack8(val[it], f);
        u32x4 w; w.x = pk2((f[0] - mean[0]) * rstd[0], (f[1] - mean[1]) * rstd[1]); w.y = pk2((f[2] - mean[2]) * rstd[2], (f[3] - mean[3]) * rstd[3]);
        w.z = pk2((f[4] - mean[4]) * rstd[4], (f[5] - mean[5]) * rstd[5]); w.w = pk2((f[6] - mean[6]) * rstd[6], (f[7] - mean[7]) * rstd[7]);
        *(u32x4*)(base + (size_t)it * 4 * TG * 2) = w;
    }
}

__device__ __forceinline__ void convglu(const P& p, int layer, bool combined, const int tid) {
    const bf16_t* AG = (const bf16_t*)(p.ws + OFF_AG); bf16_t* ACT = (bf16_t*)(p.ws + OFF_ACT);
    const float* WC = p.ffn_conv + (size_t)layer * 9 * DFF;
    const int G8 = gridDim.x >> 3, xcd = blockIdx.x & 7, bix = blockIdx.x >> 3;
    const int rows_per_b = combined ? LT : SEQ, lat0 = combined ? 256 : 0;
    constexpr int BPX = NB / 8;
    const int nlat = BPX * 32 * 8 * 352;
    for (int idx = bix * 512 + tid; idx < nlat; idx += G8 * 512) {
        const int cgl = idx & 31, cb = (idx >> 5) & 7, gr = (idx >> 8) & 31, rest = idx >> 13, cgp = (rest % 11) * 32 + cgl, bl = xcd * BPX + rest / 11;
        const int c = cgp * 8;
        const size_t row0 = (size_t)bl * rows_per_b + lat0 + gr * 64 + cb * 8;
        float acc[8][8];
#pragma unroll
        for (int o = 0; o < 8; ++o)
#pragma unroll
            for (int i = 0; i < 8; ++i) acc[o][i] = 0.f;
#pragma unroll
        for (int dr = 0; dr < 3; ++dr) {
            const int rr = gr + dr - 1;
            if (rr < 0 || rr >= 32) continue;
            u32x4 win[10];
#pragma unroll
            for (int dc = 0; dc < 10; ++dc) {
                const int cc = cb * 8 + dc - 1;
                win[dc] = (u32x4){0u, 0u, 0u, 0u};
                if (cc >= 0 && cc < 64) win[dc] = *(const u32x4*)(AG + (row0 + (long)(dr - 1) * 64 + (dc - 1)) * 5632 + DFF + c);
            }
            float wt[3][8];
#pragma unroll
            for (int t3 = 0; t3 < 3; ++t3) { const f32x4 w0 = *(const f32x4*)(WC + (dr * 3 + t3) * DFF + c), w1 = *(const f32x4*)(WC + (dr * 3 + t3) * DFF + c + 4);
                wt[t3][0] = w0[0]; wt[t3][1] = w0[1]; wt[t3][2] = w0[2]; wt[t3][3] = w0[3]; wt[t3][4] = w1[0]; wt[t3][5] = w1[1]; wt[t3][6] = w1[2]; wt[t3][7] = w1[3]; }
#pragma unroll
            for (int dc = 0; dc < 10; ++dc) {
                float gv[8]; unpack8(win[dc], gv);
#pragma unroll
                for (int o = 0; o < 8; ++o) { const int t3 = dc - o;
                    if (t3 >= 0 && t3 < 3) {
#pragma unroll
                        for (int i = 0; i < 8; ++i) acc[o][i] += gv[i] * wt[t3][i]; } }
            }
        }
#pragma unroll
        for (int o = 0; o < 8; ++o) {
            float av[8]; unpack8(__builtin_nontemporal_load((const u32x4*)(AG + (row0 + o) * 5632 + c)), av);
            u32x4 w; w.x = pk2(gelu_f(acc[o][0]) * av[0], gelu_f(acc[o][1]) * av[1]); w.y = pk2(gelu_f(acc[o][2]) * av[2], gelu_f(acc[o][3]) * av[3]);
            w.z = pk2(gelu_f(acc[o][4]) * av[4], gelu_f(acc[o][5]) * av[5]); w.w = pk2(gelu_f(acc[o][6]) * av[6], gelu_f(acc[o][7]) * av[7]);
            __builtin_nontemporal_store(w, (u32x4*)(ACT + (row0 + o) * DFF + c));
        }
    }
    if (combined) {
        const int nctx = BPX * 256 * 352;
        for (int idx = bix * 512 + tid; idx < nctx; idx += G8 * 512) {
            const int cgp = idx % 352, rest = idx / 352, j = rest & 255, bl = xcd * BPX + (rest >> 8);
            const int c = cgp * 8;
            const size_t row = (size_t)bl * LT + j;
            float acc[8];
#pragma unroll
            for (int i = 0; i < 8; ++i) acc[i] = 0.f;
#pragma unroll
            for (int dc = 0; dc < 3; ++dc) {
                const int jj = j + dc - 1;
                if (jj >= 0 && jj < 256) {
                    float gv[8]; unpack8(*(const u32x4*)(AG + (row + dc - 1) * 5632 + DFF + c), gv);
                    const f32x4 w0 = *(const f32x4*)(WC + (3 + dc) * DFF + c), w1 = *(const f32x4*)(WC + (3 + dc) * DFF + c + 4);
                    acc[0] += gv[0] * w0[0]; acc[1] += gv[1] * w0[1]; acc[2] += gv[2] * w0[2]; acc[3] += gv[3] * w0[3];
                    acc[4] += gv[4] * w1[0]; acc[5] += gv[5] * w1[1]; acc[6] += gv[6] * w1[2]; acc[7] += gv[7] * w1[3];
                }
            }
            float av[8]; unpack8(*(const u32x4*)(AG + row * 5632 + c), av);
            u32x4 w; w.x = pk2(gelu_f(acc[0]) * av[0], gelu_f(acc[1]) * av[1]); w.y = pk2(gelu_f(acc[2]) * av[2], gelu_f(acc[3]) * av[3]);
            w.z = pk2(gelu_f(acc[4]) * av[4], gelu_f(acc[5]) * av[5]); w.w = pk2(gelu_f(acc[6]) * av[6], gelu_f(acc[7]) * av[7]);
            *(u32x4*)(ACT + row * DFF + c) = w;
        }
    }
}

#define XB_TMO      128
#define XB_XCNT(j)  (256  + 64 * (j))
#define XB_XSUB(j)  (1280 + 64 * (j))
#define XB_XGEN(j)  (2304 + 64 * (j))
#define XB_TOP      3328
#define XB_TOPGEN   3392
#define XCD_BAR_WORDS 3456
#define XB_SPIN_CAP (1u << 22)
__device__ __forceinline__ unsigned xb_ld(unsigned* p)              { return __hip_atomic_load(p, __ATOMIC_RELAXED, __HIP_MEMORY_SCOPE_AGENT); }
__device__ __forceinline__ unsigned xb_add(unsigned* p, unsigned v) { return __hip_atomic_fetch_add(p, v, __ATOMIC_RELAXED, __HIP_MEMORY_SCOPE_AGENT); }
__device__ __forceinline__ unsigned xb_xcc_id() { return (unsigned)__builtin_amdgcn_s_getreg((3 << 11) | 20) & 0xFu; }
#define XB_SPIN(cond, bar) do { unsigned _sp = 0; while (cond) { __builtin_amdgcn_s_sleep(1); \
    if ((++_sp & 255u) == 0u) { if (xb_ld(&(bar)[XB_TMO])) break; if (_sp > XB_SPIN_CAP) { atomicAdd(&(bar)[XB_TMO], 1u); break; } } } } while (0)
struct XcdBarrier { unsigned* bar; unsigned x; volatile LAS unsigned* st; };
__device__ __forceinline__ XcdBarrier xcd_barrier_post(unsigned* bar, volatile LAS unsigned* st, bool leader) {
    XcdBarrier b; b.bar = bar; b.x = xb_xcc_id(); b.st = st;
    if (leader) (void)xb_add(&bar[XB_XCNT(b.x)], 1u);
    return b;
}
__device__ __forceinline__ void xcd_barrier_complete(unsigned* bar, unsigned x, unsigned& nloc, unsigned& nx) {
    const unsigned G = gridDim.x * gridDim.y * gridDim.z;
    unsigned sum, cnt, mine, sp = 0u;
    for (;;) {
        sum = 0u; cnt = 0u; mine = 0u;
#pragma unroll
        for (unsigned j = 0; j < 16; ++j) { const unsigned c = xb_ld(&bar[XB_XCNT(j)]); sum += c; cnt += (c > 0u) ? 1u : 0u; mine = (j == x) ? c : mine; }
        if (sum == G) break;
        __builtin_amdgcn_s_sleep(1);
        if ((++sp & 255u) == 0u) { if (xb_ld(&bar[XB_TMO])) break; if (sp > XB_SPIN_CAP) { atomicAdd(&bar[XB_TMO], 1u); break; } }
    }
    nloc = mine > 0u ? mine : 1u; nx = cnt > 0u ? cnt : 1u;
}
__device__ __forceinline__ void xcd_barrier(const XcdBarrier& b, bool leader) {
    asm volatile("s_waitcnt vmcnt(0)" ::: "memory");
    __syncthreads();
    if (leader) {
        unsigned* bar = b.bar;
        __builtin_amdgcn_s_waitcnt(0);
        unsigned nloc = b.st[0], nx = b.st[1];
        if (nloc == 0u) { xcd_barrier_complete(bar, b.x, nloc, nx); b.st[0] = nloc; b.st[1] = nx; }
        const unsigned old = xb_add(&bar[XB_XSUB(b.x)], 1u);
        const unsigned gen = old / nloc;
        if (old + 1u == (gen + 1u) * nloc) {
            __builtin_amdgcn_fence(__ATOMIC_RELEASE, "agent");
            asm volatile("s_waitcnt vmcnt(0)" ::: "memory");
            const unsigned og = xb_add(&bar[XB_TOP], 1u);
            const unsigned tg = og / nx;
            if (og + 1u == (tg + 1u) * nx) xb_add(&bar[XB_TOPGEN], 1u);
            else XB_SPIN(xb_ld(&bar[XB_TOPGEN]) == tg, bar);
            __builtin_amdgcn_fence(__ATOMIC_ACQUIRE, "agent");
            xb_add(&bar[XB_XGEN(b.x)], 1u);
            asm volatile("s_waitcnt vmcnt(0)" ::: "memory");
        } else {
            XB_SPIN(xb_ld(&bar[XB_XGEN(b.x)]) == gen, bar);
            __builtin_amdgcn_fence(__ATOMIC_ACQUIRE, "agent");
            asm volatile("s_waitcnt vmcnt(0)" ::: "memory");
        }
    }
    __syncthreads();
}

struct Args { const float* in[22]; float* out; unsigned char* ws; int ph_lo, ph_hi; };

__global__ void __launch_bounds__(512, 2) mega(Args a) {
    extern __shared__ __attribute__((aligned(16))) unsigned char shm[];
    LAS unsigned char* lds = (LAS unsigned char*)shm;
    cg::grid_group grid = cg::this_grid();
    typedef const __attribute__((address_space(4))) Args* KArgPtr;
#define LOAD_P() KArgPtr ap = (KArgPtr)__builtin_amdgcn_kernarg_segment_ptr(); asm volatile("" : "+s"(ap)); P p; \
    p.x = ap->in[0]; p.c = ap->in[1]; p.ctx = ap->in[2]; p.c_ctx = ap->in[3]; p.ada_w = ap->in[4]; p.ada_b = ap->in[5]; p.pre_g = ap->in[6]; p.post_g = ap->in[7]; \
    p.ffn_up = ap->in[8]; p.ffn_conv = ap->in[9]; p.ffn_down = ap->in[10]; p.ab_w_in = ap->in[11]; p.ab_qk_conv = ap->in[12]; p.ab_gate_b = ap->in[13]; p.ab_sgu_w = ap->in[14]; \
    p.ab_sgu_b = ap->in[15]; p.ab_head_g = ap->in[16]; p.ab_w_out = ap->in[17]; p.ret_w_in = ap->in[18]; p.ret_decay = ap->in[19]; p.ret_head_g = ap->in[20]; p.ret_w_out = ap->in[21]; \
    p.out = ap->out; p.ws = ap->ws;
    const int G = gridDim.x, NGW = G * 8;
    const int lo = a.ph_lo, hi = a.ph_hi;
    int pc = 0;
    const bool fused = (hi - lo) > 1;
    const int wave0 = __builtin_amdgcn_readfirstlane((int)threadIdx.x >> 6);
#define LANE_ID() ([]() __attribute__((always_inline)) { int l_; asm volatile("v_mbcnt_lo_u32_b32 %0, -1, 0\n\tv_mbcnt_hi_u32_b32 %0, -1, %0" : "=v"(l_)); return l_; }())
#define IS_LEADER() (wave0 == 0 && LANE_ID() == 0)
    volatile LAS unsigned* xst = (volatile LAS unsigned*)(lds + LDS_BYTES - 64);
    if (IS_LEADER()) { xst[0] = 0u; xst[1] = 0u; }
    __syncthreads();
    XcdBarrier xb; xb.bar = (unsigned*)(a.ws + OFF_BAR); xb.x = 0; xb.st = xst;
    if (fused) xb = xcd_barrier_post((unsigned*)(a.ws + OFF_BAR), xst, IS_LEADER());
#ifndef ONLY_PHASE
#define ONLY_PHASE -1
#endif
#ifndef DUP_MASK
#define DUP_MASK 0
#endif
#define PH_BEGIN(k) if ((ONLY_PHASE < 0 || ONLY_PHASE == (k)) && pc >= lo && pc < hi) for (int rep_ = 0; rep_ <= ((DUP_MASK >> (k)) & 1); ++rep_) { \
    if (DUP_MASK) __syncthreads(); \
    LOAD_P(); int tid = wave0 * 64 + LANE_ID(); asm volatile("" : "+v"(tid)); unsigned char* ws = p.ws; \
    const int wave = __builtin_amdgcn_readfirstlane(tid >> 6), lane = tid & 63, gw = blockIdx.x * 8 + wave; (void)lane; (void)gw; \
    const float* MOD = (const float*)(ws + OFF_MOD); bf16_t* H = (bf16_t*)(ws + OFF_H); bf16_t* Y = (bf16_t*)(ws + OFF_Y); float* CTXR = (float*)(ws + OFF_CTXR); \
    (void)MOD; (void)H; (void)Y; (void)CTXR;
#define PH_END } ++pc; if (pc > lo && pc < hi) { if (pc == lo + 1) grid.sync(); else xcd_barrier(xb, IS_LEADER()); }


    PH_BEGIN(0) prologue(p, lds, tid); PH_END

#pragma unroll 1
    for (int g = 0; g < NGRP; ++g) {
        const int b0 = g * NB;
        PH_BEGIN(1)
        __syncthreads();
        for (int idx = tid; idx < 16 * 1024; idx += 512) { const int gq = idx >> 10, k = idx & 1023; ((LAS float*)lds)[idx] = p.ab_w_in[(size_t)k * 3088 + 1024 + gq]; }
        __syncthreads();
        for (int r0 = gw * 2; r0 < TG; r0 += NGW * 2)
        { const int rr = 0; const int r = r0 + rr; const int bl = r / LT, j = r % LT, b = b0 + bl;
            const float* xs = j < 256 ? p.ctx + ((size_t)b * 256 + j) * 1024 : p.x + ((size_t)b * SEQ + (j - 256)) * 1024;
            const float* m = MOD + (size_t)(0 * 33 + (j < 256 ? 32 : b)) * 6144;
            row_pass2<true>(xs, nullptr, nullptr, H + (size_t)r * 1024, nullptr, nullptr, p.pre_g + 0 * 1024, m, m + 1024, lane, (const LAS float*)lds, p.ab_gate_b, (float*)(ws + OFF_GATES) + (size_t)r * 16); }
        PH_END
        PH_BEGIN(2)
        { pg8::Sched<pg8::G_L0IN> S; S.ws = ws; S.G = G; S.c = blockIdx.x; pg8::gemm_phase<pg8::G_L0IN>(lds, S, tid); }
        PH_END
        PH_BEGIN(3)
        for (int it = blockIdx.x; it < TG / 128; it += G) valn_block(p, lds, it, tid);
        for (int sq = gw; sq < NB * 8; sq += NGW) scan_seq(p, sq, lane);
        for (int r = gw * 4; r < TG; r += NGW * 4) conv_rows4(p, r, lane);
        PH_END
        PH_BEGIN(4)
        constexpr int N_ML = NB * 4 * 2, N_SGU = NB * 18 * 4;
        if (G >= 2 * N_ML) {
            if ((int)blockIdx.x < N_ML) { const int it = blockIdx.x; mlstm_chunk_item(p, lds, it >> 3, (it >> 1) & 3, it & 1, tid); }
            else for (int i3 = blockIdx.x - N_ML; i3 < N_SGU; i3 += G - N_ML) { const int bl = i3 / 72, rem = i3 % 72; sgu_item(p, bl, rem >> 2, rem & 3, tid); }
        } else
        for (int it = blockIdx.x; it < N_ML + N_SGU; it += G) {
            if (it < N_ML) mlstm_chunk_item(p, lds, it >> 3, (it >> 1) & 3, it & 1, tid);
            else { const int i3 = it - N_ML; const int bl = i3 / 72, rem = i3 % 72; sgu_item(p, bl, rem >> 2, rem & 3, tid); }
        }
        PH_END
        PH_BEGIN(20)
        for (int r = gw * 2; r < TG; r += NGW * 2) mlstm_post_row(p, r, lane);
        PH_END
        PH_BEGIN(5)
        { pg8::Sched<pg8::G_OUT0> S; S.ws = ws; S.G = G; S.c = blockIdx.x; pg8::gemm_phase<pg8::G_OUT0>(lds, S, tid); }
        PH_END
        PH_BEGIN(6)
        for (int r0 = gw * 2; r0 < TG; r0 += NGW * 2)
        { const int rr = 0; const int r = r0 + rr; const int bl = r / LT, j = r % LT, b = b0 + bl;
            const float* xs = j < 256 ? p.ctx + ((size_t)b * 256 + j) * 1024 : p.x + ((size_t)b * SEQ + (j - 256)) * 1024;
            float* xd = j < 256 ? CTXR + ((size_t)bl * 256 + j) * 1024 : p.out + ((size_t)b * SEQ + (j - 256)) * 1024;
            const float* m = MOD + (size_t)(0 * 33 + (j < 256 ? 32 : b)) * 6144;
            row_pass2<false>(xs, Y + (size_t)r * 1024, xd, H + (size_t)r * 1024, p.post_g + 0 * 1024, m + 2 * 1024, p.pre_g + 1 * 1024, m + 3 * 1024, m + 4 * 1024, lane); }
        PH_END
        PH_BEGIN(7)
        { pg8::Sched<pg8::G_UP0> S; S.ws = ws; S.G = G; S.c = blockIdx.x; pg8::gemm_phase<pg8::G_UP0>(lds, S, tid); }
        PH_END
        PH_BEGIN(8) convglu(p, 0, true, tid); PH_END
        PH_BEGIN(9)
        { pg8::Sched<pg8::G_DN0> S; S.ws = ws; S.G = G; S.c = blockIdx.x; pg8::gemm_phase<pg8::G_DN0>(lds, S, tid); }
        PH_END
        PH_BEGIN(10)
        constexpr int NCB = (TG - TL) / 256 * 4;
        if (G >= 2 * NCB && (int)blockIdx.x < NCB) {
            pg8::Sched<pg8::G_DN0C> S; S.ws = ws; S.G = NCB; S.c = blockIdx.x; pg8::gemm_phase<pg8::G_DN0C>(lds, S, tid);
        } else {
            const bool split = G >= 2 * NCB;
            if (!split) { pg8::Sched<pg8::G_DN0C> S; S.ws = ws; S.G = G; S.c = blockIdx.x; pg8::gemm_phase<pg8::G_DN0C>(lds, S, tid); }
            const int gw2 = split ? ((int)blockIdx.x - NCB) * 8 + wave : gw, ngw2 = split ? (G - NCB) * 8 : NGW;
            for (int r0 = gw2 * 2; r0 < TL; r0 += ngw2 * 2)
            { const int rr = 0; const int rl = r0 + rr; const int bl = rl / SEQ, t = rl % SEQ, b = b0 + bl; const size_t r = (size_t)bl * LT + 256 + t;
                float* xd = p.out + ((size_t)b * SEQ + t) * 1024;
                const float* m0 = MOD + (size_t)(0 * 33 + b) * 6144;
                const float* m1 = MOD + (size_t)(1 * 33 + b) * 6144;
                row_pass2<false>(xd, Y + r * 1024, xd, H + r * 1024, p.post_g + 1 * 1024, m0 + 5 * 1024, p.pre_g + 2 * 1024, m1, m1 + 1024, lane); }
        }
        PH_END
        PH_BEGIN(21)
        for (int r0 = gw * 2; r0 < NB * 256; r0 += NGW * 2)
        { const int rr = 0; const int rc = r0 + rr; const int bl = rc >> 8, j = rc & 255; const size_t r = (size_t)bl * LT + j;
            float* xd = CTXR + ((size_t)bl * 256 + j) * 1024;
            const float* m0 = MOD + (size_t)(0 * 33 + 32) * 6144;
            const float* m1 = MOD + (size_t)(1 * 33 + 32) * 6144;
            row_pass2<false>(xd, Y + r * 1024, xd, H + r * 1024, p.post_g + 1 * 1024, m0 + 5 * 1024, p.pre_g + 2 * 1024, m1, m1 + 1024, lane); }
        PH_END
        PH_BEGIN(11)
        { pg8::Sched<pg8::G_L1IN> S; S.ws = ws; S.G = G; S.c = blockIdx.x; pg8::gemm_phase<pg8::G_L1IN>(lds, S, tid); }
        { pg8::Sched<pg8::G_L1B> S; S.ws = ws; S.G = G; S.c = blockIdx.x; pg8::gemm_phase<pg8::G_L1B>(lds, S, tid); }
        PH_END
        PH_BEGIN(12)
        for (int it0 = blockIdx.x; it0 < NB * 4 * 4; it0 += G) {
            const int it = (G == 256) ? (((it0 & 7) * 8 + ((it0 >> 3) >> 2)) * 4 + ((it0 >> 3) & 3)) : it0;
            const int bl = it / 16, rem = it % 16; ret_chunk_item(p, lds, bl, rem >> 2, rem & 3, tid); }
        PH_END
        PH_BEGIN(19)
        for (int r = gw * 2; r < TL; r += NGW * 2) ret_post_row(p, r, lane);
        PH_END
        PH_BEGIN(13)
        { pg8::Sched<pg8::G_OUT1> S; S.ws = ws; S.G = G; S.c = blockIdx.x; pg8::gemm_phase<pg8::G_OUT1>(lds, S, tid); }
        PH_END
        PH_BEGIN(14)
        for (int r0 = gw * 2; r0 < TL; r0 += NGW * 2)
        { const int rr = 0; const int r = r0 + rr; const int bl = r / SEQ, t = r % SEQ, b = b0 + bl;
            float* xd = p.out + ((size_t)b * SEQ + t) * 1024;
            const float* m1 = MOD + (size_t)(1 * 33 + b) * 6144;
            row_pass2<false>(xd, Y + (size_t)r * 1024, xd, H + (size_t)r * 1024, p.post_g + 2 * 1024, m1 + 2 * 1024, p.pre_g + 3 * 1024, m1 + 3 * 1024, m1 + 4 * 1024, lane); }
        PH_END
        PH_BEGIN(15)
        { pg8::Sched<pg8::G_UP1> S; S.ws = ws; S.G = G; S.c = blockIdx.x; pg8::gemm_phase<pg8::G_UP1>(lds, S, tid); }
        PH_END
        PH_BEGIN(16) convglu(p, 1, false, tid); PH_END
        PH_BEGIN(17)
        { pg8::Sched<pg8::G_DN1> S; S.ws = ws; S.G = G; S.c = blockIdx.x; pg8::gemm_phase<pg8::G_DN1>(lds, S, tid); }
        PH_END
        PH_BEGIN(18)
        for (int r0 = gw * 2; r0 < TL; r0 += NGW * 2)
        { const int rr = 0; const int r = r0 + rr; const int bl = r / SEQ, t = r % SEQ, b = b0 + bl;
            float* xd = p.out + ((size_t)b * SEQ + t) * 1024;
            const float* m1 = MOD + (size_t)(1 * 33 + b) * 6144;
            row_pass2<false>(xd, Y + (size_t)r * 1024, xd, nullptr, p.post_g + 3 * 1024, m1 + 5 * 1024, nullptr, nullptr, nullptr, lane); }
        PH_END
    }
#undef PH_BEGIN
#undef PH_END
}

extern "C" void kernel_launch(void* const* d_in, const int* in_sizes, int n_in, void* d_out, int out_size, void* d_ws, size_t ws_size, hipStream_t stream) {
    static int grid = 0;
    if (grid == 0) {
        if (n_in != 22 || ws_size < WS_END) { fprintf(stderr, "kernel_launch: need 22 inputs and %zu bytes of workspace; got %d, %zu\n", (size_t)WS_END, n_in, ws_size); grid = -1; return; }
        int dev = 0, cus = 0, per_cu = 0;
        hipGetDevice(&dev);
        hipDeviceGetAttribute(&cus, hipDeviceAttributeMultiprocessorCount, dev);
        if (hipFuncSetAttribute((const void*)mega, hipFuncAttributeMaxDynamicSharedMemorySize, LDS_BYTES) != hipSuccess) { fprintf(stderr, "kernel_launch: hipFuncSetAttribute failed\n"); grid = -1; return; }
        if (hipOccupancyMaxActiveBlocksPerMultiprocessor(&per_cu, (const void*)mega, 512, LDS_BYTES) != hipSuccess || per_cu < 1) { fprintf(stderr, "kernel_launch: occupancy query says %d\n", per_cu); per_cu = 1; }
        (void)hipGetLastError();
        grid = cus * per_cu;
        if (grid <= 0) grid = 256;
    }
    if (grid < 0) return;
    Args a{};
    for (int i = 0; i < 22; ++i) a.in[i] = (const float*)d_in[i];
    a.out = (float*)d_out; a.ws = (unsigned char*)d_ws;
#if MK_MULTI
    for (int ph = 0; ph < NPHASE; ++ph) {
        a.ph_lo = ph; a.ph_hi = ph + 1;
        hipLaunchKernelGGL(mega, dim3(grid), dim3(512), LDS_BYTES, stream, a);
    }
#else
    a.ph_lo = 0; a.ph_hi = NPHASE;
    if (hipMemsetAsync((char*)d_ws + OFF_BAR, 0, (size_t)XCD_BAR_WORDS_C * 4, stream) != hipSuccess) { fprintf(stderr, "kernel_launch: memset failed\n"); return; }
    void* args[] = {&a};
    hipError_t e = hipLaunchCooperativeKernel((const void*)mega, dim3(grid), dim3(512), args, LDS_BYTES, stream);
    if (e != hipSuccess) fprintf(stderr, "cooperative launch failed: %s (grid %d)\n", hipGetErrorString(e), grid);
#endif
}
```
